# Optimizing an MI355X kernel written in HIP

```python
import math
import jax, jax.numpy as jnp
from jax import lax
import numpy as np

D_MODEL = 1024
BATCH = 8
SEQ = 2048
DEPTH = 1
DEC_BATCH = 128
DEC_SEQ = 8
PAST_LEN = 16384
PAGE_SIZE = 128

MIX_WIDTH = D_MODEL
GLA_HEADS = 4
GLA_DV = (MIX_WIDTH // 2) // GLA_HEADS
GLA_DK = GLA_DV // 2
GLA_QK = GLA_HEADS * GLA_DK
GLA_V = GLA_HEADS * GLA_DV
GLA_GATE_RANK = 16
GLA_GATE_TAU = 16.0
GDN_HEADS = 4
GDN_DK = (MIX_WIDTH // 2) // GDN_HEADS
GDN_DV = GDN_DK
GDN_QK = GDN_HEADS * GDN_DK
GDN_V = GDN_HEADS * GDN_DV
GDN_CONV_DIM = 2 * GDN_QK + GDN_V
CONV_W = 4
IN_SIZES = (GLA_QK, GLA_QK, GLA_V, GLA_V, GLA_GATE_RANK, GDN_CONV_DIM, GDN_V, GDN_HEADS, GDN_HEADS)
IN_DIM = sum(IN_SIZES)
D_FF = -(-8 * D_MODEL // (3 * 256)) * 256
CHUNK = 64
NORM_EPS = 1e-5
L2_EPS = 1e-6
DN_ALPHA = (2 * DEPTH) ** 0.25
DN_BETA = (8 * DEPTH) ** -0.25

kernel_name = "hybrid_gla_gdn_deepnorm_step"


def _layer_norm(x, g, b):
    x32 = x.astype(jnp.float32)
    mu = jnp.mean(x32, -1, keepdims=True)
    var = jnp.mean(jnp.square(x32 - mu), -1, keepdims=True)
    return ((x32 - mu) * lax.rsqrt(var + NORM_EPS) * g + b).astype(x.dtype)


def _rms_norm(x, g):
    x32 = x.astype(jnp.float32)
    return x32 * lax.rsqrt(jnp.mean(jnp.square(x32), -1, keepdims=True) + NORM_EPS) * g.astype(jnp.float32)


def _l2_norm(x):
    return x * lax.rsqrt(jnp.sum(jnp.square(x), -1, keepdims=True) + L2_EPS)


def _to_chunks(a, c, n):
    b_, t_, h_, d_ = a.shape
    a = jnp.pad(a, ((0, 0), (0, n * c - t_), (0, 0), (0, 0)))
    return a.reshape(b_, n, c, h_, d_).transpose(1, 0, 3, 2, 4)


def _from_chunks(o, t_):
    n, b_, h_, c, d_ = o.shape
    return o.transpose(1, 0, 3, 2, 4).reshape(b_, n * c, h_, d_)[:, :t_]


def gla_chunked(q, k, v, log_a, s0):
    t_ = q.shape[1]
    c = min(CHUNK, t_)
    n = -(-t_ // c)
    qc, kc, vc, gc = (_to_chunks(a, c, n) for a in (q, k, v, log_a))
    causal = jnp.tril(jnp.ones((c, c), bool))

    def step(s, inp):
        qi, ki, vi, gi = inp
        b = jnp.cumsum(gi, axis=2)
        diff = b[:, :, :, None, :] - b[:, :, None, :, :]
        decay = jnp.exp(jnp.where(causal[:, :, None], diff, -jnp.inf))
        attn = jnp.einsum('bhid,bhjd,bhijd->bhij', qi, ki, decay)
        o = (jnp.einsum('bhij,bhjv->bhiv', attn, vi)
             + jnp.einsum('bhid,bhdv->bhiv', qi * jnp.exp(b), s))
        b_last = b[:, :, -1:, :]
        s = (jnp.exp(b_last[:, :, 0, :])[..., None] * s
             + jnp.einsum('bhjd,bhjv->bhdv', ki * jnp.exp(b_last - b), vi))
        return s, o

    s, o = lax.scan(step, s0, (qc, kc, vc, gc))
    return _from_chunks(o, t_), s


def gdn_chunked(q, k, v, g, beta, s0):
    t_ = q.shape[1]
    dv = v.shape[-1]
    c = min(CHUNK, t_)
    n = -(-t_ // c)
    qc, kc, vc = (_to_chunks(a, c, n) for a in (q, k, v))
    gc, bc = (_to_chunks(a[..., None], c, n)[..., 0] for a in (g, beta))
    causal = jnp.tril(jnp.ones((c, c), bool))
    strict = jnp.tril(jnp.ones((c, c), bool), -1)
    eye = jnp.eye(c, dtype=jnp.float32)

    def step(s, inp):
        qi, ki, vi, gi, bi = inp
        gcum = jnp.cumsum(gi, -1)
        gamma = jnp.exp(jnp.where(causal, gcum[..., :, None] - gcum[..., None, :], -jnp.inf))
        kk = jnp.einsum('bhid,bhjd->bhij', ki, ki)
        a_mat = eye + jnp.where(strict, bi[..., :, None] * kk * gamma, 0.0)
        rhs = jnp.concatenate([vi * bi[..., None], ki * (bi * jnp.exp(gcum))[..., None]], -1)
        sol = lax.linalg.triangular_solve(a_mat, rhs, left_side=True, lower=True, unit_diagonal=True)
        u, w = sol[..., :dv], sol[..., dv:]
        delta = u - jnp.einsum('bhid,bhdv->bhiv', w, s)
        qk = jnp.einsum('bhid,bhjd->bhij', qi, ki) * gamma
        o = (jnp.einsum('bhid,bhdv->bhiv', qi * jnp.exp(gcum)[..., None], s)
             + jnp.einsum('bhij,bhjv->bhiv', qk, delta))
        s = (jnp.exp(gcum[..., -1])[..., None, None] * s
             + jnp.einsum('bhjd,bhjv->bhdv', ki * jnp.exp(gcum[..., -1:] - gcum)[..., None], delta))
        return s, o

    s, o = lax.scan(step, s0, (qc, kc, vc, gc, bc))
    return _from_chunks(o, t_), s


def hybrid_mixer(x, s_gla, s_gdn, conv_buf, w_in, gla_w_gate_up, gla_b_gate, gla_norm_g,
                 gdn_conv_w, gdn_a_log, gdn_dt_bias, gdn_norm_g, w_out):
    f32 = jnp.float32
    bsz, t_, _ = x.shape
    h = jnp.einsum('btd,de->bte', x, w_in).astype(f32)
    parts = []
    off = 0
    for n_cols in IN_SIZES:
        parts.append(h[..., off:off + n_cols])
        off += n_cols
    gq, gk, gv, gg, ga, dqkv, dg, da, db = parts

    q = gq.reshape(bsz, t_, GLA_HEADS, GLA_DK) * GLA_DK ** -0.5
    k = gk.reshape(bsz, t_, GLA_HEADS, GLA_DK)
    v = gv.reshape(bsz, t_, GLA_HEADS, GLA_DV)
    z = jnp.einsum('btr,re->bte', ga, gla_w_gate_up.astype(f32)) + gla_b_gate.astype(f32)
    log_a = (jax.nn.log_sigmoid(z) / GLA_GATE_TAU).reshape(bsz, t_, GLA_HEADS, GLA_DK)
    o_gla, s_gla_new = gla_chunked(q, k, v, log_a, s_gla.astype(f32))
    o_gla = _rms_norm(o_gla, gla_norm_g) * jax.nn.silu(gg.reshape(bsz, t_, GLA_HEADS, GLA_DV))

    xc = jnp.concatenate([conv_buf.astype(f32), dqkv], axis=1)
    cw = gdn_conv_w.astype(f32)
    conv = xc[:, 0:t_] * cw[0]
    for i in range(1, CONV_W):
        conv = conv + xc[:, i:i + t_] * cw[i]
    conv = jax.nn.silu(conv)
    new_buf = xc[:, -(CONV_W - 1):]
    dq = _l2_norm(conv[..., :GDN_QK].reshape(bsz, t_, GDN_HEADS, GDN_DK)) * GDN_DK ** -0.5
    dk = _l2_norm(conv[..., GDN_QK:2 * GDN_QK].reshape(bsz, t_, GDN_HEADS, GDN_DK))
    dvv = conv[..., 2 * GDN_QK:].reshape(bsz, t_, GDN_HEADS, GDN_DV)
    g = -jnp.exp(gdn_a_log.astype(f32)) * jax.nn.softplus(da + gdn_dt_bias.astype(f32))
    beta = jax.nn.sigmoid(db)
    o_gdn, s_gdn_new = gdn_chunked(dq, dk, dvv, g, beta, s_gdn.astype(f32))
    o_gdn = _rms_norm(o_gdn, gdn_norm_g) * jax.nn.silu(dg.reshape(bsz, t_, GDN_HEADS, GDN_DV))

    o = jnp.concatenate([o_gla.reshape(bsz, t_, GLA_V), o_gdn.reshape(bsz, t_, GDN_V)], -1).astype(x.dtype)
    out = jnp.einsum('bte,ed->btd', o, w_out)
    dt_s = s_gla.dtype
    return out, s_gla_new.astype(dt_s), s_gdn_new.astype(dt_s), new_buf.astype(conv_buf.dtype)


def trunk_layer(x, s_gla, s_gdn, conv_buf, w_in, gla_w_gate_up, gla_b_gate, gla_norm_g,
                gdn_conv_w, gdn_a_log, gdn_dt_bias, gdn_norm_g, w_out, ln1_g, ln1_b,
                w_ffn_gate, w_ffn_up, w_ffn_down, ln2_g, ln2_b):
    m, s_gla_new, s_gdn_new, buf_new = hybrid_mixer(
        x, s_gla, s_gdn, conv_buf, w_in, gla_w_gate_up, gla_b_gate, gla_norm_g,
        gdn_conv_w, gdn_a_log, gdn_dt_bias, gdn_norm_g, w_out)
    x = _layer_norm(DN_ALPHA * x + m, ln1_g, ln1_b)
    hid = jax.nn.silu(jnp.einsum('btd,df->btf', x, w_ffn_gate)) * jnp.einsum('btd,df->btf', x, w_ffn_up)
    f = jnp.einsum('btf,fd->btd', hid, w_ffn_down)
    x = _layer_norm(DN_ALPHA * x + f, ln2_g, ln2_b)
    return x, s_gla_new, s_gdn_new, buf_new


def setup_inputs(seed: int = 0) -> dict:
    key = jax.random.key(seed)
    ks = jax.random.split(key, 24)
    f32 = jnp.float32
    L = DEPTH

    def nrm(k, shape, s):
        return jax.random.normal(k, shape, f32) * s

    dt = jnp.exp(jax.random.uniform(ks[11], (L, GDN_HEADS), f32, math.log(1e-3), math.log(1e-1)))
    return {
        "x_prompt": nrm(ks[0], (BATCH, SEQ, D_MODEL), 1.0),
        "x_sample": nrm(ks[1], (DEC_BATCH, DEC_SEQ, D_MODEL), 1.0),
        "state_gla": nrm(ks[2], (L, DEC_BATCH, GLA_HEADS, GLA_DK, GLA_DV), 0.5),
        "state_gdn": nrm(ks[3], (L, DEC_BATCH, GDN_HEADS, GDN_DK, GDN_DV), 0.5),
        "state_gdn_conv": nrm(ks[4], (L, DEC_BATCH, CONV_W - 1, GDN_CONV_DIM), 1.0),
        "w_in": nrm(ks[5], (L, D_MODEL, IN_DIM), D_MODEL ** -0.5),
        "gla_w_gate_up": nrm(ks[6], (L, GLA_GATE_RANK, GLA_QK), GLA_GATE_RANK ** -0.5),
        "gla_b_gate": nrm(ks[7], (L, GLA_QK), 0.1),
        "gla_norm_g": 1.0 + nrm(ks[8], (L, GLA_DV), 0.02),
        "gdn_conv_w": nrm(ks[9], (L, CONV_W, GDN_CONV_DIM), CONV_W ** -0.5),
        "gdn_a_log": jnp.log(jax.random.uniform(ks[10], (L, GDN_HEADS), f32, 1.0, 16.0)),
        "gdn_dt_bias": dt + jnp.log(-jnp.expm1(-dt)),
        "gdn_norm_g": 1.0 + nrm(ks[12], (L, GDN_DV), 0.02),
        "w_out": nrm(ks[13], (L, MIX_WIDTH, D_MODEL), DN_BETA * MIX_WIDTH ** -0.5),
        "ln1_g": 1.0 + nrm(ks[14], (L, D_MODEL), 0.02),
        "ln1_b": nrm(ks[15], (L, D_MODEL), 0.02),
        "w_ffn_gate": nrm(ks[16], (L, D_MODEL, D_FF), D_MODEL ** -0.5),
        "w_ffn_up": nrm(ks[17], (L, D_MODEL, D_FF), D_MODEL ** -0.5),
        "w_ffn_down": nrm(ks[18], (L, D_FF, D_MODEL), DN_BETA * D_FF ** -0.5),
        "ln2_g": 1.0 + nrm(ks[19], (L, D_MODEL), 0.02),
        "ln2_b": nrm(ks[20], (L, D_MODEL), 0.02),
    }


def reference(x_prompt, x_sample, state_gla, state_gdn, state_gdn_conv, w_in, gla_w_gate_up,
              gla_b_gate, gla_norm_g, gdn_conv_w, gdn_a_log, gdn_dt_bias, gdn_norm_g, w_out,
              ln1_g, ln1_b, w_ffn_gate, w_ffn_up, w_ffn_down, ln2_g, ln2_b):
    bp = x_prompt.shape[0]
    yp, ys = x_prompt, x_sample
    p_gla, p_gdn, p_conv, s_gla, s_gdn, s_conv = [], [], [], [], [], []
    for l in range(DEPTH):
        params = (w_in[l], gla_w_gate_up[l], gla_b_gate[l], gla_norm_g[l], gdn_conv_w[l],
                  gdn_a_log[l], gdn_dt_bias[l], gdn_norm_g[l], w_out[l], ln1_g[l], ln1_b[l],
                  w_ffn_gate[l], w_ffn_up[l], w_ffn_down[l], ln2_g[l], ln2_b[l])
        z_gla = jnp.zeros((bp, GLA_HEADS, GLA_DK, GLA_DV), state_gla.dtype)
        z_gdn = jnp.zeros((bp, GDN_HEADS, GDN_DK, GDN_DV), state_gdn.dtype)
        z_conv = jnp.zeros((bp, CONV_W - 1, GDN_CONV_DIM), state_gdn_conv.dtype)
        yp, a1, a2, a3 = trunk_layer(yp, z_gla, z_gdn, z_conv, *params)
        ys, b1, b2, b3 = trunk_layer(ys, state_gla[l], state_gdn[l], state_gdn_conv[l], *params)
        p_gla.append(a1); p_gdn.append(a2); p_conv.append(a3)
        s_gla.append(b1); s_gdn.append(b2); s_conv.append(b3)
    return (yp, ys, jnp.stack(p_gla), jnp.stack(p_gdn), jnp.stack(p_conv),
            jnp.stack(s_gla), jnp.stack(s_gdn), jnp.stack(s_conv))
```

```cpp
#include <hip/hip_runtime.h>
#include <hip/hip_cooperative_groups.h>
#include <cstdio>
namespace cg = cooperative_groups;
namespace pg8 {
#define PG8_LAS __attribute__((address_space(3)))
typedef unsigned short bf16_t;
typedef short bf16x8 __attribute__((ext_vector_type(8)));
typedef float f32x4 __attribute__((ext_vector_type(4)));
typedef unsigned u32x4 __attribute__((ext_vector_type(4)));
constexpr int BM = 256, BK = 64, HALF = 128, HTB = HALF * BK * 2  , STAGE_BYTES = 8 * HTB, NXCD = 8, WGM = 8;

__host__ __device__ __forceinline__ int lds_byte(int r, int c) { const int st = (r >> 4) * 2 + (c >> 5), rr = r & 15, cc = c & 31, ob = rr * 64 + cc * 2; return st * 1024 + (ob ^ (((ob >> 9) & 1) << 5)); }
__host__ __device__ __forceinline__ void stage_rc(int b, int& R, int& C) { const int st = b / 1024, sb = b % 1024, swz = sb ^ (((sb >> 9) & 1) << 5); R = (st >> 1) * 16 + swz / 64; C = (st & 1) * 32 + (swz % 64) / 2; }
__host__ __device__ __forceinline__ int perm32(int rho) { const int n = rho >> 4, i = rho & 15; return 8 * (i >> 2) + 4 * n + (i & 3); }

struct Unit { int pm, pn; };
struct Gemm { const bf16_t* A; const bf16_t* Bt; int M, N, K; };

struct StaticOrder {
    int nM, nN, nwg, G, c;
    __host__ __device__ void init(int M, int N, int G_, int c_) { nM = M / BM; nN = N / BM; nwg = nM * nN; G = G_; c = c_; }
    __host__ __device__ bool next(int i, Unit& u) const {
        const long L = (long)i * G + c; if (L >= nwg) return false;
        int wgid = (int)L; { const int q = nwg / NXCD, r = nwg % NXCD, xcd = wgid % NXCD, off = wgid / NXCD; wgid = (xcd < r ? xcd * (q + 1) : r * (q + 1) + (xcd - r) * q) + off; }
        const int nig = WGM * nN, gid = wgid / nig, fm = gid * WGM, gsz = (nM - fm) < WGM ? (nM - fm) : WGM;
        u.pm = fm + ((wgid % nig) % gsz); u.pn = (wgid % nig) / gsz; return true;
    }
    __device__ __forceinline__ void a_ready(const Unit&) const {}
    __device__ __forceinline__ void done(const Unit&) const {}
};
__device__ __forceinline__ unsigned cvt_pk_bf16(float lo, float hi) { unsigned r; asm volatile("v_cvt_pk_bf16_f32 %0, %1, %2" : "=v"(r) : "v"(lo), "v"(hi)); return r; }
typedef float f32x2 __attribute__((ext_vector_type(2)));
__device__ __forceinline__ f32x2 gelu_pk(f32x2 v) {
    const f32x2 av = __builtin_elementwise_abs(v), d = av * 0.2316418882f + 1.0f;
    f32x2 t; t.x = __builtin_amdgcn_rcpf(d.x); t.y = __builtin_amdgcn_rcpf(d.y);
    f32x2 q = t * 0.5307027145f + (-0.7265760135f); q = q * t + 0.7107068705f; q = q * t + (-0.142248368f); q = q * t + 0.127414796f; q = q * t;
    const f32x2 s = (v * v) * (-0.72134752044f);
    f32x2 e; e.x = __builtin_amdgcn_exp2f(s.x); e.y = __builtin_amdgcn_exp2f(s.y);
    const f32x2 m = v * (q * e), r = v - m;
    f32x2 o; o.x = v.x < 0.f ? m.x : r.x; o.y = v.y < 0.f ? m.y : r.y; return o;
}

struct EpiF32 {
    static constexpr bool PERM = false, AFTER_DRAIN = false;
    float* C; int ldc; const float* bias;
    __device__ __forceinline__ void operator()(const f32x4 (&acc)[2][2][4][2], const Unit& u, int wr, int wc, int fr, int fq) const {
        const int row0 = u.pm * BM + wr * 64 + fr, col0 = u.pn * BM + wc * 32 + 4 * fq;
        f32x4 bv[2][2];
#pragma unroll
        for (int bj = 0; bj < 2; ++bj)
#pragma unroll
            for (int n = 0; n < 2; ++n) bv[bj][n] = bias ? *(const f32x4*)(bias + col0 + bj * HALF + n * 16) : (f32x4){0.f, 0.f, 0.f, 0.f};
#pragma unroll
        for (int ai = 0; ai < 2; ++ai)
#pragma unroll
            for (int m = 0; m < 4; ++m) { float* rowp = C + (size_t)(row0 + ai * HALF + m * 16) * ldc + col0;
#pragma unroll
                for (int bj = 0; bj < 2; ++bj)
#pragma unroll
                    for (int n = 0; n < 2; ++n) *(f32x4*)(rowp + bj * HALF + n * 16) = acc[ai][bj][m][n] + bv[bj][n]; }
    }
};
struct PanelStats {
    unsigned* xbuf;
    unsigned* cnt;
    unsigned* tmo;
    int ntn; float eps;
    unsigned code;
    __device__ __forceinline__ bool run(const f32x4 (&v)[2][2][4][2], const Unit& u, int wr, int wc, int fr, int fq, PG8_LAS unsigned char* lds, int wid, int lane) const {
        typedef float f32x2v __attribute__((ext_vector_type(2)));
        PG8_LAS f32x2v* P = (PG8_LAS f32x2v*)lds;
        PG8_LAS f32x2v* S = (PG8_LAS f32x2v*)(lds + 8192);
        PG8_LAS unsigned* flag = (PG8_LAS unsigned*)(lds + 8192 + 2048);
#pragma unroll
        for (int ai = 0; ai < 2; ++ai)
#pragma unroll
            for (int m = 0; m < 4; ++m) {
                float s = 0.f;
#pragma unroll
                for (int bj = 0; bj < 2; ++bj)
#pragma unroll
                    for (int n = 0; n < 2; ++n) { const f32x4 x = v[ai][bj][m][n]; s += (x[0] + x[1]) + (x[2] + x[3]); }
                s += __shfl_xor(s, 16); s += __shfl_xor(s, 32);
                const float mw = s * (1.0f / 64.0f); float q = 0.f;
#pragma unroll
                for (int bj = 0; bj < 2; ++bj)
#pragma unroll
                    for (int n = 0; n < 2; ++n) { const f32x4 d = v[ai][bj][m][n] - mw; q += (d[0] * d[0] + d[1] * d[1]) + (d[2] * d[2] + d[3] * d[3]); }
                q += __shfl_xor(q, 16); q += __shfl_xor(q, 32);
                if (fq == 0) P[(ai * HALF + wr * 64 + m * 16 + fr) * 4 + wc] = (f32x2v){mw, q};
            }
        asm volatile("s_waitcnt lgkmcnt(0)" ::: "memory"); __builtin_amdgcn_s_barrier(); asm volatile("" ::: "memory");
#if defined(BROKEN_NO_WAIT)
        if (blockIdx.x >= 64) { const long long t0 = clock64(); while (clock64() - t0 < 60000) __builtin_amdgcn_s_sleep(8); }
#endif
        const int row = wid * 32 + (lane & 31);
        if (lane < 32) {
            const f32x2v a = P[row * 4 + 0], b = P[row * 4 + 1], c = P[row * 4 + 2], d = P[row * 4 + 3];
            const float mt = (a.x + b.x + c.x + d.x) * 0.25f;
            const float da = a.x - mt, db = b.x - mt, dc = c.x - mt, dd = d.x - mt;
            const float m2 = (a.y + b.y) + (c.y + d.y) + 64.0f * ((da * da + db * db) + (dc * dc + dd * dd));
            unsigned long long* slot = (unsigned long long*)xbuf + ((size_t)(u.pm * BM + row) * 4 + u.pn);
            __hip_atomic_store(slot, ((unsigned long long)__float_as_uint(m2) << 32) | __float_as_uint(mt), __ATOMIC_RELAXED, __HIP_MEMORY_SCOPE_AGENT);
        }
        asm volatile("s_waitcnt vmcnt(0)" ::: "memory");
        if (lane == 0) __hip_atomic_fetch_add(cnt + 64 * u.pm, 1u, __ATOMIC_RELAXED, __HIP_MEMORY_SCOPE_AGENT);
        if (wid == 0) {
            bool dead = false; const unsigned long long t0 = __builtin_amdgcn_s_memrealtime(); const unsigned want = 8u * (unsigned)ntn;
            for (;;) {
#if defined(BROKEN_NO_WAIT)
                break;
#endif
                if ((unsigned)__builtin_amdgcn_readfirstlane(__hip_atomic_load(cnt + 64 * u.pm, __ATOMIC_RELAXED, __HIP_MEMORY_SCOPE_AGENT)) >= want) break;
                if (__builtin_amdgcn_s_memrealtime() - t0 > 2000000ull) {
                    if (lane == 0) { unsigned expect = 0u; __hip_atomic_compare_exchange_strong(tmo + 1, &expect, code | (unsigned)(u.pm & 0xff), __ATOMIC_RELAXED, __ATOMIC_RELAXED, __HIP_MEMORY_SCOPE_AGENT);
                                     __hip_atomic_store(tmo, 1u, __ATOMIC_RELAXED, __HIP_MEMORY_SCOPE_AGENT); }
                    dead = true; break; }
                __builtin_amdgcn_s_sleep(2);
            }
            __builtin_amdgcn_fence(__ATOMIC_ACQUIRE, "agent");
            if (lane == 0) flag[0] = dead ? 1u : 0u;
        }
        asm volatile("s_waitcnt vmcnt(0) lgkmcnt(0)" ::: "memory"); __builtin_amdgcn_s_barrier(); asm volatile("" ::: "memory");
        const bool bad = flag[0] != 0u;
        if (lane < 32) {
            const unsigned long long* slot = (const unsigned long long*)xbuf + (size_t)(u.pm * BM + row) * 4; float mt[4], m2[4]; float ms = 0.f;
#pragma unroll
            for (int t = 0; t < 4; ++t) { if (t < ntn) { const unsigned long long w = __hip_atomic_load(slot + t, __ATOMIC_RELAXED, __HIP_MEMORY_SCOPE_AGENT); mt[t] = __uint_as_float((unsigned)w); m2[t] = __uint_as_float((unsigned)(w >> 32)); } else { mt[t] = 0.f; m2[t] = 0.f; } ms += mt[t]; }
            const float mean = ms / (float)ntn; float q = 0.f;
#pragma unroll
            for (int t = 0; t < 4; ++t) if (t < ntn) { const float dm = mt[t] - mean; q += m2[t] + 256.0f * dm * dm; }
            S[row] = (f32x2v){mean, 1.0f / sqrtf(q / (256.0f * (float)ntn) + eps)};
        }
        asm volatile("s_waitcnt lgkmcnt(0)" ::: "memory"); __builtin_amdgcn_s_barrier(); asm volatile("" ::: "memory");
        return bad;
    }
};
template <class Epi, class Sched, bool STAMP = false>
__device__ __forceinline__ void gemm_phase(PG8_LAS unsigned char* lds, const Gemm g, const Sched& S, const Epi& E, unsigned long long* stamps) {
    const int tid = threadIdx.x, wid = __builtin_amdgcn_readfirstlane(tid >> 6), lane = tid & 63, wr = wid >> 2, wc = wid & 3, fr = lane & 15, fq = lane >> 4;
    const int K = g.K, nt = K / BK;
    int ts_lo = 0, ts_hi = 0, nts = 0; const unsigned long long rt_entry = STAMP ? (unsigned long long)wall_clock64() : 0ull;
#define PG8_STAMP() do { if (STAMP && wid == 0 && nts < 64) { const unsigned long long _c = (unsigned long long)clock64(); \
        ts_lo = (lane == nts) ? (int)(unsigned)_c : ts_lo; ts_hi = (lane == nts) ? (int)(unsigned)(_c >> 32) : ts_hi; ++nts; } } while (0)
    PG8_STAMP();
    unsigned voffA[2], voffB[2];
#pragma unroll
    for (int i = 0; i < 2; ++i) { int R, C; stage_rc(tid * 16 + i * 8192, R, C); const int Rb = Epi::PERM ? ((R & ~31) + perm32(R & 31)) : R;
        voffA[i] = (unsigned)(R * K + C) * 2u; voffB[i] = (unsigned)(Rb * K + C) * 2u; }
    const size_t kstep = (size_t)(BK * 2);
    const size_t hstep = (size_t)HALF * K * 2;
    const size_t tstep = 2 * hstep;
    const unsigned ldsw = (unsigned)wid * 1024u;
    const int aoff = lds_byte(wr * 64 + fr, fq * 8), boff = lds_byte(wc * 32 + fr, fq * 8);
#define PG8_SA(b, h) (((b) * 2 + (h)) * HTB)
#define PG8_SB(b, h) ((4 + (b) * 2 + (h)) * HTB)
#define PG8_STAGE(bufoff, gbase, voff) do { _Pragma("unroll") for (int _i = 0; _i < 2; ++_i) \
        __builtin_amdgcn_global_load_lds((const unsigned*)((const char*)(gbase) + (voff)[_i]), (PG8_LAS unsigned*)(lds + (bufoff) + ldsw + _i * 8192), 16, 0, 0); } while (0)
#define PG8_LDA(dst, b, h) do { _Pragma("unroll") for (int m = 0; m < 4; ++m) _Pragma("unroll") for (int k = 0; k < 2; ++k) dst[m][k] = *(const PG8_LAS bf16x8*)(lds + PG8_SA(b, h) + aoff + m * 2048 + k * 1024); } while (0)
#define PG8_LDB(dst, b, h) do { _Pragma("unroll") for (int n = 0; n < 2; ++n) _Pragma("unroll") for (int k = 0; k < 2; ++k) dst[n][k] = *(const PG8_LAS bf16x8*)(lds + PG8_SB(b, h) + boff + n * 2048 + k * 1024); } while (0)
#define PG8_MMA(ai, bj, At, Bt) do { __builtin_amdgcn_s_setprio(1); _Pragma("unroll") for (int m = 0; m < 4; ++m) _Pragma("unroll") for (int n = 0; n < 2; ++n) _Pragma("unroll") for (int k = 0; k < 2; ++k) \
        acc[ai][bj][m][n] = __builtin_amdgcn_mfma_f32_16x16x32_bf16(Bt[n][k], At[m][k], acc[ai][bj][m][n], 0, 0, 0); __builtin_amdgcn_s_setprio(0); } while (0)
#define PG8_WAIT_V(n) asm volatile("s_waitcnt vmcnt(" #n ")" ::: "memory")
#define PG8_WAIT_L(n) asm volatile("s_waitcnt lgkmcnt(" #n ")" ::: "memory")
#define PG8_BAR __builtin_amdgcn_s_barrier()
#define PG8_SCHED __builtin_amdgcn_sched_barrier(0)
    Unit cur, nxt; int ui = 0;
    if (!S.next(0, cur)) return;
    f32x4 acc[2][2][4][2];
#pragma unroll
    for (int a = 0; a < 2; ++a)
#pragma unroll
        for (int b = 0; b < 2; ++b)
#pragma unroll
            for (int m = 0; m < 4; ++m)
#pragma unroll
                for (int n = 0; n < 2; ++n) acc[a][b][m][n] = (f32x4){0.f, 0.f, 0.f, 0.f};
    bf16x8 At[4][2], B0[2][2], B1[2][2];
    const char* cA = (const char*)g.A + (size_t)cur.pm * tstep; const char* cB = (const char*)g.Bt + (size_t)cur.pn * tstep;
    S.a_ready(cur);
    PG8_STAGE(PG8_SB(0, 0), cB, voffB); PG8_STAGE(PG8_SA(0, 0), cA, voffA); PG8_STAGE(PG8_SB(0, 1), cB + hstep, voffB); PG8_STAGE(PG8_SA(0, 1), cA + hstep, voffA);
    if (wr == 1) PG8_BAR;
    PG8_WAIT_V(4); PG8_BAR;
    PG8_STAGE(PG8_SB(1, 0), cB + kstep, voffB); PG8_STAGE(PG8_SA(1, 0), cA + kstep, voffA); PG8_STAGE(PG8_SB(1, 1), cB + hstep + kstep, voffB);
    PG8_WAIT_V(6); PG8_BAR;
    PG8_STAMP();
    for (;;) {
        const bool has_next = S.next(ui + 1, nxt);
        const char* nA = has_next ? (const char*)g.A + (size_t)nxt.pm * tstep : cA; const char* nB = has_next ? (const char*)g.Bt + (size_t)nxt.pn * tstep : cB;
        for (int t = 0; t < nt; t += 2) {
            const bool last = (t == nt - 2);
            const char* a1 = cA + (size_t)(t + 1) * kstep;
            const char* a2 = last ? nA : cA + (size_t)(t + 2) * kstep; const char* b2 = last ? nB : cB + (size_t)(t + 2) * kstep;
            const char* a3 = a2 + kstep; const char* b3 = b2 + kstep;
            if (last && has_next) S.a_ready(nxt);
            PG8_LDB(B0, 0, 0); PG8_SCHED; PG8_LDA(At, 0, 0); PG8_STAGE(PG8_SA(1, 1), a1 + hstep, voffA);
            PG8_WAIT_L(8); PG8_BAR; PG8_WAIT_L(0); PG8_MMA(0, 0, At, B0); PG8_BAR; PG8_SCHED;
            PG8_LDB(B1, 0, 1); PG8_STAGE(PG8_SB(0, 0), b2, voffB);
            PG8_BAR; PG8_WAIT_L(0); PG8_MMA(0, 1, At, B1); PG8_BAR;
            PG8_LDA(At, 0, 1); PG8_STAGE(PG8_SA(0, 0), a2, voffA);
            PG8_BAR; PG8_WAIT_L(0); PG8_MMA(1, 0, At, B0); PG8_BAR; PG8_SCHED;
            PG8_STAGE(PG8_SB(0, 1), b2 + hstep, voffB);
            PG8_WAIT_V(6); PG8_BAR; PG8_MMA(1, 1, At, B1); PG8_BAR;
            PG8_LDB(B0, 1, 0); PG8_SCHED; PG8_LDA(At, 1, 0); PG8_STAGE(PG8_SA(0, 1), a2 + hstep, voffA);
            PG8_WAIT_L(8); PG8_BAR; PG8_WAIT_L(0); PG8_MMA(0, 0, At, B0); PG8_BAR; PG8_SCHED;
            PG8_LDB(B1, 1, 1); PG8_STAGE(PG8_SB(1, 0), b3, voffB);
            PG8_BAR; PG8_WAIT_L(0); PG8_MMA(0, 1, At, B1); PG8_BAR;
            PG8_LDA(At, 1, 1); PG8_STAGE(PG8_SA(1, 0), a3, voffA);
            PG8_BAR; PG8_WAIT_L(0); PG8_MMA(1, 0, At, B0); PG8_BAR; PG8_SCHED;
            PG8_STAGE(PG8_SB(1, 1), b3 + hstep, voffB);
            PG8_WAIT_V(6); PG8_BAR; PG8_MMA(1, 1, At, B1); PG8_BAR;
        }
        PG8_STAMP();
        if constexpr (!Epi::AFTER_DRAIN) { E(acc, cur, wr, wc, fr, fq); S.done(cur); }
        PG8_STAMP();
        if (!has_next) break;
#pragma unroll
        for (int a = 0; a < 2; ++a)
#pragma unroll
            for (int b = 0; b < 2; ++b)
#pragma unroll
                for (int m = 0; m < 4; ++m)
#pragma unroll
                    for (int n = 0; n < 2; ++n) acc[a][b][m][n] = (f32x4){0.f, 0.f, 0.f, 0.f};
        cur = nxt; cA = nA; cB = nB; ++ui;
    }
    PG8_WAIT_V(0);
    if (wr == 0) PG8_BAR;
    PG8_BAR;
    if constexpr (Epi::AFTER_DRAIN) { E.fused(acc, cur, wr, wc, fr, fq, lds, wid, lane); S.done(cur); }
    PG8_STAMP();
    if (STAMP && wid == 0) { stamps[lane] = lane < nts ? (((unsigned long long)(unsigned)ts_hi << 32) | (unsigned)ts_lo) : 0ull;
        if (lane == 62) stamps[62] = rt_entry; if (lane == 63) stamps[63] = (unsigned long long)wall_clock64(); }
#undef PG8_STAMP
#undef PG8_SA
#undef PG8_SB
#undef PG8_STAGE
#undef PG8_LDA
#undef PG8_LDB
#undef PG8_MMA
#undef PG8_WAIT_V
#undef PG8_WAIT_L
#undef PG8_BAR
#undef PG8_SCHED
}
}
using pg8::bf16_t; using pg8::f32x4; using pg8::u32x4; using pg8::Unit;
typedef unsigned u32x2 __attribute__((ext_vector_type(2)));
#define LAS3 __attribute__((address_space(3)))

constexpr int DM = 1024, NPR = 16384, NSR = 1024, MT = 17408, HN = 3584, N1 = 3840, FF = 2816, NGU = 5632;
constexpr float DN_ALPHA = 1.189207115002721f;
constexpr size_t O_Y = 0, O_GLA_P = 17825792, O_GDN_P = 18087936, O_CONV_P = 18612224, O_GLA_S = 18649088, O_GDN_S = 22843392, O_CONV_S = 31232000;
constexpr size_t WS_CTL = 0, WS_WIN = 4096, WS_WOUT = WS_WIN + (size_t)N1 * DM * 2, WS_WGU = WS_WOUT + (size_t)DM * DM * 2, WS_WD = WS_WGU + (size_t)NGU * DM * 2,
                 WS_A = WS_WD + (size_t)DM * FF * 2, WS_H = WS_A + (size_t)MT * DM * 2, WS_P = WS_H + (size_t)MT * HN * 2,
                 WS_QKV = WS_P, WS_LA = WS_QKV + (size_t)MT * 1536 * 2, WS_GB = WS_LA + (size_t)MT * 256 * 4, WS_HS = WS_GB + (size_t)MT * 8 * 4, WS_END = WS_HS + (size_t)MT * 32 * 4,
                 WS_X1F = WS_H, WS_HID = WS_H + (size_t)MT * DM * 4;
static_assert(WS_HID + (size_t)MT * FF * 2 <= WS_END, "hid fits");

struct Params {
    const float *xp, *xs, *sgla, *sgdn, *sconv, *w_in, *wup, *bgate, *gla_ng, *convw, *alog, *dtb, *gdn_ng, *w_out, *ln1g, *ln1b, *wg, *wu, *wd, *ln2g, *ln2b;
    float* out; unsigned char* ws; int lo, hi;
};

__device__ __forceinline__ unsigned pk2(float lo, float hi) { return pg8::cvt_pk_bf16(lo, hi); }
__device__ __forceinline__ float bf2f(bf16_t b) { return __uint_as_float((unsigned)b << 16); }
__device__ __forceinline__ float bflo(unsigned w) { return __uint_as_float(w << 16); }
__device__ __forceinline__ float bfhi(unsigned w) { return __uint_as_float(w & 0xffff0000u); }
__device__ __forceinline__ float wave_sum(float v) {
#pragma unroll
    for (int o = 1; o < 64; o <<= 1) v += __shfl_xor(v, o);
    return v;
}
__device__ __forceinline__ float silu_f(float x) { return x / (1.0f + __expf(-x)); }

struct EpiH {
    static constexpr bool PERM = true, AFTER_DRAIN = false;
    bf16_t* H; float* HS;
    __device__ __forceinline__ void operator()(const f32x4 (&acc)[2][2][4][2], const Unit& u, int wr, int wc, int fr, int fq) const {
        const int row0 = u.pm * 256 + wr * 64 + fr;
        if (u.pn < 14) {
            const int col0 = u.pn * 256 + wc * 32 + 8 * fq;
#pragma unroll
            for (int ai = 0; ai < 2; ++ai)
#pragma unroll
                for (int m = 0; m < 4; ++m) { bf16_t* rowp = H + (size_t)(row0 + ai * 128 + m * 16) * HN + col0;
#pragma unroll
                    for (int bj = 0; bj < 2; ++bj) { const f32x4 v0 = acc[ai][bj][m][0], v1 = acc[ai][bj][m][1];
                        u32x4 w; w.x = pk2(v0[0], v0[1]); w.y = pk2(v0[2], v0[3]); w.z = pk2(v1[0], v1[1]); w.w = pk2(v1[2], v1[3]);
                        *(u32x4*)(rowp + bj * 128) = w; } }
        } else if (wc == 0) {
#pragma unroll
            for (int ai = 0; ai < 2; ++ai)
#pragma unroll
                for (int m = 0; m < 4; ++m) { float* rowp = HS + (size_t)(row0 + ai * 128 + m * 16) * 32 + 8 * fq;
                    *(f32x4*)rowp = acc[ai][0][m][0]; *(f32x4*)(rowp + 4) = acc[ai][0][m][1]; }
        }
    }
};
struct EpiSwiGLU {
    static constexpr bool PERM = true, AFTER_DRAIN = false;
    bf16_t* O;
    __device__ __forceinline__ void operator()(const f32x4 (&acc)[2][2][4][2], const Unit& u, int wr, int wc, int fr, int fq) const {
        const int row0 = u.pm * 256 + wr * 64 + fr, col0 = u.pn * 128 + wc * 32 + 8 * fq;
#pragma unroll
        for (int ai = 0; ai < 2; ++ai)
#pragma unroll
            for (int m = 0; m < 4; ++m) { bf16_t* rowp = O + (size_t)(row0 + ai * 128 + m * 16) * FF + col0;
                f32x4 r0, r1;
#pragma unroll
                for (int j = 0; j < 4; ++j) { r0[j] = silu_f(acc[ai][0][m][0][j]) * acc[ai][1][m][0][j]; r1[j] = silu_f(acc[ai][0][m][1][j]) * acc[ai][1][m][1][j]; }
                u32x4 w; w.x = pk2(r0[0], r0[1]); w.y = pk2(r0[2], r0[3]); w.z = pk2(r1[0], r1[1]); w.w = pk2(r1[2], r1[3]);
                *(u32x4*)rowp = w; }
    }
};

__device__ __forceinline__ int map_win(int r) { return r < 1536 ? r : (r < 3584 ? r + 16 : (r < 3600 ? 1536 + (r - 3584) : (r < 3608 ? r : -1))); }
template <int WHICH>
__device__ __forceinline__ void transpose_item(const Params& P, float* scr, int item, int lane) {
    constexpr int K = (WHICH == 3) ? FF : DM;
    constexpr int NDST = (WHICH == 0) ? N1 : (WHICH == 2 ? NGU : DM);
    constexpr int NSRC = (WHICH == 0) ? 3608 : (WHICH == 2 ? FF : DM);
    constexpr int nblk = NDST / 32;
    const int kb = item / nblk, nb = item % nblk, k0 = 64 * kb, n0 = 32 * nb;
    const int r = n0 + (lane & 31);
    const float* W; int sc;
    if (WHICH == 0) { W = P.w_in; sc = map_win(r); }
    else if (WHICH == 1) { W = P.w_out; sc = r; }
    else if (WHICH == 2) { const int pn = r >> 8, wi = r & 255; W = (wi < 128) ? P.wg : P.wu; sc = pn * 128 + (wi & 127); }
    else { W = P.wd; sc = r; }
    bf16_t* WT = (bf16_t*)(P.ws + (WHICH == 0 ? WS_WIN : WHICH == 1 ? WS_WOUT : WHICH == 2 ? WS_WGU : WS_WD));
#pragma unroll 8
    for (int i = 0; i < 32; ++i) { const int kk = 2 * i + (lane >> 5); scr[kk * 33 + (lane & 31)] = sc >= 0 ? W[(size_t)(k0 + kk) * NSRC + sc] : 0.f; }
    __builtin_amdgcn_s_waitcnt(0xc07f); asm volatile("" ::: "memory");
    const int c = lane & 7;
#pragma unroll
    for (int j = 0; j < 4; ++j) { const int n = (lane >> 3) + 8 * j; const float* s = scr + (8 * c) * 33 + n;
        u32x4 o; o.x = pk2(s[0 * 33], s[1 * 33]); o.y = pk2(s[2 * 33], s[3 * 33]); o.z = pk2(s[4 * 33], s[5 * 33]); o.w = pk2(s[6 * 33], s[7 * 33]);
        *(u32x4*)(WT + (size_t)(n0 + n) * K + k0 + 8 * c) = o; }
    __builtin_amdgcn_s_waitcnt(0xc07f); asm volatile("" ::: "memory");
}
__device__ __forceinline__ void phase_convert(const Params& P, unsigned char* lds) {
    const int tid = threadIdx.x, lane = tid & 63, wave = tid >> 6, gw = blockIdx.x * 8 + wave, NGW = gridDim.x * 8;
    float* scr = (float*)lds + wave * (64 * 33);
    constexpr int I0 = (DM / 64) * (N1 / 32), I1 = (DM / 64) * (DM / 32), I2 = (DM / 64) * (NGU / 32), I3 = (FF / 64) * (DM / 32);
    for (int it = gw; it < I0 + I1 + I2 + I3; it += NGW) {
        int r = it;
        if (r < I0) { transpose_item<0>(P, scr, r, lane); continue; } r -= I0;
        if (r < I1) { transpose_item<1>(P, scr, r, lane); continue; } r -= I1;
        if (r < I2) { transpose_item<2>(P, scr, r, lane); continue; } r -= I2;
        transpose_item<3>(P, scr, r, lane);
    }
    bf16_t* XB = (bf16_t*)(P.ws + WS_A);
    for (int row = gw; row < MT; row += NGW) {
        const float* src = row < NPR ? P.xp + (size_t)row * DM : P.xs + (size_t)(row - NPR) * DM;
#pragma unroll
        for (int j = 0; j < 4; ++j) { const f32x4 v = *(const f32x4*)(src + lane * 4 + 256 * j); u32x2 w; w.x = pk2(v[0], v[1]); w.y = pk2(v[2], v[3]);
            *(u32x2*)(XB + (size_t)row * DM + lane * 4 + 256 * j) = w; }
    }
}

__device__ __forceinline__ float log_sigmoid_f(float z) { return fminf(z, 0.f) - log1pf(expf(-fabsf(z))); }
__device__ __forceinline__ float softplus_f(float z) { return fmaxf(z, 0.f) + log1pf(expf(-fabsf(z))); }
__device__ __forceinline__ void phase_prep(const Params& P) {
    const int tid = threadIdx.x, lane = tid & 63, wave = tid >> 6, gw = blockIdx.x * 8 + wave, NGW = gridDim.x * 8;
    const bf16_t* H = (const bf16_t*)(P.ws + WS_H); const float* HS = (const float*)(P.ws + WS_HS);
    float* LA = (float*)(P.ws + WS_LA); float* GB = (float*)(P.ws + WS_GB); bf16_t* QKV = (bf16_t*)(P.ws + WS_QKV);
    {
        f32x4 wv[16];
#pragma unroll
        for (int r = 0; r < 16; ++r) wv[r] = *(const f32x4*)(P.wup + r * 256 + lane * 4);
        const f32x4 bias = *(const f32x4*)(P.bgate + lane * 4);
        const float na = (lane < 4) ? -expf(P.alog[lane]) : 0.f, dtb = (lane < 4) ? P.dtb[lane] : 0.f;
        for (int row = gw; row < MT; row += NGW) {
            const float* hsr = HS + (size_t)row * 32;
            f32x4 z = bias;
#pragma unroll
            for (int r4 = 0; r4 < 4; ++r4) { const f32x4 g4 = *(const f32x4*)(hsr + 4 * r4);
#pragma unroll
                for (int j = 0; j < 4; ++j) z += g4[j] * wv[r4 * 4 + j]; }
            f32x4 la;
#pragma unroll
            for (int j = 0; j < 4; ++j) la[j] = log_sigmoid_f(z[j]) * (1.0f / 16.0f);
            *(f32x4*)(LA + (size_t)row * 256 + lane * 4) = la;
            if (lane < 4) { const float da = hsr[16 + lane], db = hsr[20 + lane];
                GB[(size_t)row * 8 + lane] = na * softplus_f(da + dtb); GB[(size_t)row * 8 + 4 + lane] = 1.0f / (1.0f + expf(-db)); }
        }
    }
    for (int w = gw; w < (MT / 8) * 12; w += NGW) {
        const int tile = w / 12, gi = w % 12, r0 = tile * 8, cb = gi * 128 + 2 * lane;
        const bool prompt = r0 < NPR; const bool seq_start = prompt ? ((r0 & 2047) == 0) : true;
        const int bs = prompt ? (r0 >> 11) : ((r0 - NPR) >> 3);
        float x0[11], x1[11];
#pragma unroll
        for (int j = 0; j < 11; ++j) {
            if (j >= 3 || !seq_start) { const unsigned wd = *(const unsigned*)(H + (size_t)(r0 - 3 + j) * HN + 1536 + cb); x0[j] = bflo(wd); x1[j] = bfhi(wd); }
            else if (prompt) { x0[j] = 0.f; x1[j] = 0.f; }
            else { const float* s = P.sconv + ((size_t)bs * 3 + j) * 1536 + cb; x0[j] = s[0]; x1[j] = s[1]; }
        }
        float c0w[4], c1w[4];
#pragma unroll
        for (int i = 0; i < 4; ++i) { c0w[i] = P.convw[i * 1536 + cb]; c1w[i] = P.convw[i * 1536 + cb + 1]; }
#pragma unroll
        for (int t = 0; t < 8; ++t) {
            float c0 = 0.f, c1 = 0.f;
#pragma unroll
            for (int i = 0; i < 4; ++i) { c0 += c0w[i] * x0[t + i]; c1 += c1w[i] * x1[t + i]; }
            c0 = silu_f(c0); c1 = silu_f(c1);
            if (gi < 8) { const float ss = wave_sum(c0 * c0 + c1 * c1); const float sc = rsqrtf(ss + 1e-6f) * (gi < 4 ? 0.08838834764831845f : 1.0f); c0 *= sc; c1 *= sc; }
            *(unsigned*)(QKV + (size_t)(r0 + t) * 1536 + cb) = pk2(c0, c1);
        }
        if (prompt) { if ((r0 & 2047) == 2040) {
#pragma unroll
                for (int j = 0; j < 3; ++j) { float* o = P.out + O_CONV_P + ((size_t)bs * 3 + j) * 1536 + cb; o[0] = x0[8 + j]; o[1] = x1[8 + j]; } } }
        else {
#pragma unroll
            for (int j = 0; j < 3; ++j) { float* o = P.out + O_CONV_S + ((size_t)bs * 3 + j) * 1536 + cb; o[0] = x0[8 + j]; o[1] = x1[8 + j]; } }
    }
}

__device__ __forceinline__ void unpack16_to_lds(float* dst, const u32x4& a, const u32x4& c) {
    *(f32x4*)(dst + 0) = (f32x4){bflo(a.x), bfhi(a.x), bflo(a.y), bfhi(a.y)}; *(f32x4*)(dst + 4) = (f32x4){bflo(a.z), bfhi(a.z), bflo(a.w), bfhi(a.w)};
    *(f32x4*)(dst + 8) = (f32x4){bflo(c.x), bfhi(c.x), bflo(c.y), bfhi(c.y)}; *(f32x4*)(dst + 12) = (f32x4){bflo(c.z), bfhi(c.z), bflo(c.w), bfhi(c.w)};
}
__device__ __forceinline__ void rec_gdn(const Params& P, float* lds, int seq) {
    const int tid = threadIdx.x, p = tid >> 7, v = tid & 127, wave = tid >> 6, lane = tid & 63;
    const bool prompt = seq < 8; const int b = prompt ? seq : seq - 8; const int T = prompt ? 2048 : 8;
    const size_t row0 = prompt ? (size_t)b * 2048 : (size_t)NPR + (size_t)b * 8;
    const bf16_t* QKV = (const bf16_t*)(P.ws + WS_QKV); const float* GB = (const float*)(P.ws + WS_GB); const bf16_t* H = (const bf16_t*)(P.ws + WS_H);
    bf16_t* OM = (bf16_t*)(P.ws + WS_A);
    float S[128];
    if (prompt) {
#pragma unroll
        for (int d = 0; d < 128; ++d) S[d] = 0.f;
    } else { const float* s0 = P.sgdn + ((size_t)(b * 4 + p) * 128) * 128 + v;
#pragma unroll
        for (int d = 0; d < 128; ++d) S[d] = s0[(size_t)d * 128]; }
    float* qs = lds; float* ks = lds + 8 * 512; float* part = lds + 16 * 512; float* gbs = part + 16;
    const float ng = P.gdn_ng[v];
    for (int t0 = 0; t0 < T; t0 += 8) {
        __syncthreads();
        { const int tt = tid >> 6; const bf16_t* src = QKV + (row0 + t0 + tt) * 1536 + lane * 16; const u32x4 a = *(const u32x4*)src, c = *(const u32x4*)(src + 8);
          unpack16_to_lds((lane < 32 ? qs : ks) + tt * 512 + (lane & 31) * 16, a, c); }
        if (tid < 64) gbs[tid] = GB[(row0 + t0) * 8 + tid];
        float vv[8], gt[8];
#pragma unroll
        for (int tt = 0; tt < 8; ++tt) { const size_t row = row0 + t0 + tt;
            vv[tt] = bf2f(QKV[row * 1536 + 1024 + p * 128 + v]); gt[tt] = bf2f(H[row * HN + 3072 + p * 128 + v]); }
        __syncthreads();
#pragma unroll 1
        for (int tt = 0; tt < 8; ++tt) {
            const float a = __expf(gbs[tt * 8 + p]); const float beta = gbs[tt * 8 + 4 + p];
            const f32x4* kp = (const f32x4*)(ks + tt * 512 + p * 128); const f32x4* qp = (const f32x4*)(qs + tt * 512 + p * 128);
            float kS0 = 0.f, kS1 = 0.f;
#pragma unroll
            for (int g8 = 0; g8 < 4; ++g8) {
#pragma unroll
                for (int d4 = 8 * g8; d4 < 8 * g8 + 8; ++d4) { const f32x4 k4 = kp[d4]; kS0 += k4[0] * S[4 * d4] + k4[2] * S[4 * d4 + 2]; kS1 += k4[1] * S[4 * d4 + 1] + k4[3] * S[4 * d4 + 3]; }
                asm volatile("" ::: "memory"); }
            const float dl = beta * (vv[tt] - a * (kS0 + kS1));
            float o0 = 0.f, o1 = 0.f;
#pragma unroll
            for (int g8 = 0; g8 < 8; ++g8) {
#pragma unroll
                for (int d4 = 4 * g8; d4 < 4 * g8 + 4; ++d4) { const f32x4 k4 = kp[d4], q4 = qp[d4];
                    S[4 * d4] = a * S[4 * d4] + k4[0] * dl; S[4 * d4 + 1] = a * S[4 * d4 + 1] + k4[1] * dl; S[4 * d4 + 2] = a * S[4 * d4 + 2] + k4[2] * dl; S[4 * d4 + 3] = a * S[4 * d4 + 3] + k4[3] * dl;
                    o0 += q4[0] * S[4 * d4] + q4[2] * S[4 * d4 + 2]; o1 += q4[1] * S[4 * d4 + 1] + q4[3] * S[4 * d4 + 3]; }
                asm volatile("" ::: "memory"); }
            const float o = o0 + o1; const float ss = wave_sum(o * o);
            if (lane == 0) part[(tt & 1) * 8 + wave] = ss;
            __syncthreads();
            const float tot = part[(tt & 1) * 8 + 2 * p] + part[(tt & 1) * 8 + 2 * p + 1];
            const float r = rsqrtf(tot * (1.0f / 128.0f) + 1e-5f);
            const float val = o * r * ng * silu_f(gt[tt]);
            OM[(row0 + t0 + tt) * DM + 512 + p * 128 + v] = (bf16_t)(pk2(val, 0.f) & 0xffffu);
        }
    }
    float* so = P.out + (prompt ? O_GDN_P : O_GDN_S) + ((size_t)(b * 4 + p) * 128) * 128 + v;
#pragma unroll
    for (int d = 0; d < 128; ++d) so[(size_t)d * 128] = S[d];
}
__device__ __forceinline__ void rec_gla(const Params& P, float* lds, int seq) {
    const int tid = threadIdx.x, p = tid >> 7, v = tid & 127, wave = tid >> 6, lane = tid & 63;
    const bool prompt = seq < 8; const int b = prompt ? seq : seq - 8; const int T = prompt ? 2048 : 8;
    const size_t row0 = prompt ? (size_t)b * 2048 : (size_t)NPR + (size_t)b * 8;
    const float* LA = (const float*)(P.ws + WS_LA); const bf16_t* H = (const bf16_t*)(P.ws + WS_H);
    bf16_t* OM = (bf16_t*)(P.ws + WS_A);
    float S[64];
    if (prompt) {
#pragma unroll
        for (int d = 0; d < 64; ++d) S[d] = 0.f;
    } else { const float* s0 = P.sgla + ((size_t)(b * 4 + p) * 64) * 128 + v;
#pragma unroll
        for (int d = 0; d < 64; ++d) S[d] = s0[(size_t)d * 128]; }
    float* qs = lds; float* ks = lds + 8 * 256; float* as = lds + 16 * 256; float* part = lds + 24 * 256;
    const float ng = P.gla_ng[v];
    for (int t0 = 0; t0 < T; t0 += 8) {
        __syncthreads();
        { const int tt = tid >> 6; const size_t row = row0 + t0 + tt;
          const u32x2 qw = *(const u32x2*)(H + row * HN + lane * 4), kw = *(const u32x2*)(H + row * HN + 256 + lane * 4); const f32x4 la = *(const f32x4*)(LA + row * 256 + lane * 4);
          *(f32x4*)(qs + tt * 256 + lane * 4) = (f32x4){bflo(qw.x) * 0.125f, bfhi(qw.x) * 0.125f, bflo(qw.y) * 0.125f, bfhi(qw.y) * 0.125f};
          *(f32x4*)(ks + tt * 256 + lane * 4) = (f32x4){bflo(kw.x), bfhi(kw.x), bflo(kw.y), bfhi(kw.y)};
          *(f32x4*)(as + tt * 256 + lane * 4) = (f32x4){__expf(la[0]), __expf(la[1]), __expf(la[2]), __expf(la[3])}; }
        float vv[8], gt[8];
#pragma unroll
        for (int tt = 0; tt < 8; ++tt) { const size_t row = row0 + t0 + tt; vv[tt] = bf2f(H[row * HN + 512 + p * 128 + v]); gt[tt] = bf2f(H[row * HN + 1024 + p * 128 + v]); }
        __syncthreads();
#pragma unroll 1
        for (int tt = 0; tt < 8; ++tt) {
            const f32x4* kp = (const f32x4*)(ks + tt * 256 + p * 64); const f32x4* qp = (const f32x4*)(qs + tt * 256 + p * 64); const f32x4* ap = (const f32x4*)(as + tt * 256 + p * 64);
            const float vt = vv[tt]; float o0 = 0.f, o1 = 0.f;
#pragma unroll
            for (int g8 = 0; g8 < 4; ++g8) {
#pragma unroll
                for (int d4 = 4 * g8; d4 < 4 * g8 + 4; ++d4) { const f32x4 k4 = kp[d4], q4 = qp[d4], a4 = ap[d4];
                    S[4 * d4] = a4[0] * S[4 * d4] + k4[0] * vt; S[4 * d4 + 1] = a4[1] * S[4 * d4 + 1] + k4[1] * vt; S[4 * d4 + 2] = a4[2] * S[4 * d4 + 2] + k4[2] * vt; S[4 * d4 + 3] = a4[3] * S[4 * d4 + 3] + k4[3] * vt;
                    o0 += q4[0] * S[4 * d4] + q4[2] * S[4 * d4 + 2]; o1 += q4[1] * S[4 * d4 + 1] + q4[3] * S[4 * d4 + 3]; }
                asm volatile("" ::: "memory"); }
            const float o = o0 + o1; const float ss = wave_sum(o * o);
            if (lane == 0) part[(tt & 1) * 8 + wave] = ss;
            __syncthreads();
            const float tot = part[(tt & 1) * 8 + 2 * p] + part[(tt & 1) * 8 + 2 * p + 1];
            const float r = rsqrtf(tot * (1.0f / 128.0f) + 1e-5f);
            const float val = o * r * ng * silu_f(gt[tt]);
            OM[(row0 + t0 + tt) * DM + p * 128 + v] = (bf16_t)(pk2(val, 0.f) & 0xffffu);
        }
    }
    float* so = P.out + (prompt ? O_GLA_P : O_GLA_S) + ((size_t)(b * 4 + p) * 64) * 128 + v;
#pragma unroll
    for (int d = 0; d < 64; ++d) so[(size_t)d * 128] = S[d];
}
__device__ __forceinline__ void phase_rec(const Params& P, unsigned char* lds) {
    for (int task = blockIdx.x; task < 272; task += gridDim.x) {
        const bool gdn = task < 8 || (task >= 16 && task < 144);
        const int seq = task < 8 ? task : (task < 16 ? task - 8 : (task < 144 ? task - 8 : task - 136));
        if (gdn) rec_gdn(P, (float*)lds, seq); else rec_gla(P, (float*)lds, seq);
        __syncthreads();
    }
}

template <int WHICH>
__device__ __forceinline__ void phase_ln(const Params& P) {
    const int tid = threadIdx.x, lane = tid & 63, wave = tid >> 6, gw = blockIdx.x * 8 + wave, NGW = gridDim.x * 8;
    const float* G = WHICH == 1 ? P.ln1g : P.ln2g; const float* B = WHICH == 1 ? P.ln1b : P.ln2b;
    f32x4 g4[4], b4[4];
#pragma unroll
    for (int j = 0; j < 4; ++j) { g4[j] = *(const f32x4*)(G + lane * 4 + 256 * j); b4[j] = *(const f32x4*)(B + lane * 4 + 256 * j); }
    float* X1F = (float*)(P.ws + WS_X1F); bf16_t* X1B = (bf16_t*)(P.ws + WS_A);
    for (int row = gw; row < MT; row += NGW) {
        const float* base = WHICH == 1 ? (row < NPR ? P.xp + (size_t)row * DM : P.xs + (size_t)(row - NPR) * DM) : X1F + (size_t)row * DM;
        float* mrow = P.out + O_Y + (size_t)row * DM;
        f32x4 v[4]; float s = 0.f;
#pragma unroll
        for (int j = 0; j < 4; ++j) { const f32x4 xb = *(const f32x4*)(base + lane * 4 + 256 * j), mm = *(const f32x4*)(mrow + lane * 4 + 256 * j); v[j] = DN_ALPHA * xb + mm; s += (v[j][0] + v[j][1]) + (v[j][2] + v[j][3]); }
        const float mean = wave_sum(s) * (1.0f / DM); float q = 0.f;
#pragma unroll
        for (int j = 0; j < 4; ++j) { v[j] = v[j] - mean; q += (v[j][0] * v[j][0] + v[j][1] * v[j][1]) + (v[j][2] * v[j][2] + v[j][3] * v[j][3]); }
        const float rstd = rsqrtf(wave_sum(q) * (1.0f / DM) + 1e-5f);
#pragma unroll
        for (int j = 0; j < 4; ++j) { const f32x4 o = v[j] * rstd * g4[j] + b4[j];
            if (WHICH == 1) { *(f32x4*)(X1F + (size_t)row * DM + lane * 4 + 256 * j) = o; u32x2 w; w.x = pk2(o[0], o[1]); w.y = pk2(o[2], o[3]); *(u32x2*)(X1B + (size_t)row * DM + lane * 4 + 256 * j) = w; }
            else *(f32x4*)(mrow + lane * 4 + 256 * j) = o; }
    }
}

constexpr int NPHASE = 9;
__global__ void __launch_bounds__(512, 2) mega(Params P) {
    extern __shared__ __attribute__((aligned(16))) unsigned char lds[];
    cg::grid_group grid = cg::this_grid();
    const int lo = P.lo, hi = P.hi;
#ifndef PHASE_MASK
#define PHASE_MASK 0x1ff
#endif
#define IN(k) (((PHASE_MASK >> (k)) & 1) && lo <= (k) && (k) < hi)
#define SEAM(k) do { if (IN(k) && IN((k) + 1)) grid.sync(); } while (0)
    if (IN(0)) phase_convert(P, lds);
    SEAM(0);
    if (IN(1)) { pg8::Gemm g{(const bf16_t*)(P.ws + WS_A), (const bf16_t*)(P.ws + WS_WIN), MT, N1, DM}; pg8::StaticOrder S; S.init(MT, N1, gridDim.x, blockIdx.x);
        EpiH E{(bf16_t*)(P.ws + WS_H), (float*)(P.ws + WS_HS)}; pg8::gemm_phase<EpiH, pg8::StaticOrder, false>((PG8_LAS unsigned char*)lds, g, S, E, nullptr); }
    SEAM(1);
    if (IN(2)) phase_prep(P);
    SEAM(2);
    if (IN(3)) phase_rec(P, lds);
    SEAM(3);
    if (IN(4)) { pg8::Gemm g{(const bf16_t*)(P.ws + WS_A), (const bf16_t*)(P.ws + WS_WOUT), MT, DM, DM}; pg8::StaticOrder S; S.init(MT, DM, gridDim.x, blockIdx.x);
        pg8::EpiF32 E{P.out + O_Y, DM, nullptr}; pg8::gemm_phase<pg8::EpiF32, pg8::StaticOrder, false>((PG8_LAS unsigned char*)lds, g, S, E, nullptr); }
    SEAM(4);
    if (IN(5)) phase_ln<1>(P);
    SEAM(5);
    if (IN(6)) { pg8::Gemm g{(const bf16_t*)(P.ws + WS_A), (const bf16_t*)(P.ws + WS_WGU), MT, NGU, DM}; pg8::StaticOrder S; S.init(MT, NGU, gridDim.x, blockIdx.x);
        EpiSwiGLU E{(bf16_t*)(P.ws + WS_HID)}; pg8::gemm_phase<EpiSwiGLU, pg8::StaticOrder, false>((PG8_LAS unsigned char*)lds, g, S, E, nullptr); }
    SEAM(6);
    if (IN(7)) { pg8::Gemm g{(const bf16_t*)(P.ws + WS_HID), (const bf16_t*)(P.ws + WS_WD), MT, DM, FF}; pg8::StaticOrder S; S.init(MT, DM, gridDim.x, blockIdx.x);
        pg8::EpiF32 E{P.out + O_Y, DM, nullptr}; pg8::gemm_phase<pg8::EpiF32, pg8::StaticOrder, false>((PG8_LAS unsigned char*)lds, g, S, E, nullptr); }
    SEAM(7);
    if (IN(8)) phase_ln<2>(P);
#undef IN
#undef SEAM
}

#ifndef N_LAUNCHES
#define N_LAUNCHES 1
#endif
extern "C" void kernel_launch(void* const* d_in, const int* in_sizes, int n_in, void* d_out, int out_size, void* d_ws, size_t ws_size, hipStream_t stream) {
    static int grid = 0;
    constexpr int LDS_BYTES = pg8::STAGE_BYTES;
    if (grid == 0) {
        if (n_in != 21 || ws_size < WS_END) { fprintf(stderr, "kernel_launch: need 21 inputs and %zu bytes of workspace, got %d and %zu\n", (size_t)WS_END, n_in, ws_size); grid = -1; return; }
        int dev = 0, cus = 0, per_cu = 0;
        (void)hipGetDevice(&dev); (void)hipDeviceGetAttribute(&cus, hipDeviceAttributeMultiprocessorCount, dev);
        if (hipFuncSetAttribute((const void*)mega, hipFuncAttributeMaxDynamicSharedMemorySize, LDS_BYTES) != hipSuccess) { fprintf(stderr, "kernel_launch: hipFuncSetAttribute failed\n"); grid = -1; return; }
        (void)hipOccupancyMaxActiveBlocksPerMultiprocessor(&per_cu, (const void*)mega, 512, LDS_BYTES);
        (void)hipGetLastError();
        grid = cus;
        if (per_cu < 1) fprintf(stderr, "kernel_launch: occupancy query says %d blocks per CU\n", per_cu);
    }
    if (grid < 0) return;
    Params p{};
    const float** pp = (const float**)&p;
    for (int i = 0; i < 21; ++i) pp[i] = (const float*)d_in[i];
    p.out = (float*)d_out; p.ws = (unsigned char*)d_ws;
    const int cuts = N_LAUNCHES;
    for (int li = 0; li < cuts; ++li) {
        p.lo = (cuts == 1) ? 0 : li; p.hi = (cuts == 1) ? NPHASE : li + 1;
        void* args[] = {&p};
        hipError_t e = hipLaunchCooperativeKernel((const void*)mega, dim3(grid), dim3(512), args, LDS_BYTES, stream);
        if (e != hipSuccess) { fprintf(stderr, "cooperative launch %d failed: %s (grid %d)\n", li, hipGetErrorString(e), grid); break; }
    }
}
```

```cpp
#include <hip/hip_runtime.h>
#include <hip/hip_cooperative_groups.h>
#include <cstdio>
namespace cg = cooperative_groups;
namespace pg8 {
#define PG8_LAS __attribute__((address_space(3)))
typedef unsigned short bf16_t;
typedef short bf16x8 __attribute__((ext_vector_type(8)));
typedef float f32x4 __attribute__((ext_vector_type(4)));
typedef unsigned u32x4 __attribute__((ext_vector_type(4)));
constexpr int BM = 256, BK = 64, HALF = 128, HTB = HALF * BK * 2  , STAGE_BYTES = 8 * HTB, NXCD = 8, WGM = 8;

__host__ __device__ __forceinline__ int lds_byte(int r, int c) { const int st = (r >> 4) * 2 + (c >> 5), rr = r & 15, cc = c & 31, ob = rr * 64 + cc * 2; return st * 1024 + (ob ^ (((ob >> 9) & 1) << 5)); }
__host__ __device__ __forceinline__ void stage_rc(int b, int& R, int& C) { const int st = b / 1024, sb = b % 1024, swz = sb ^ (((sb >> 9) & 1) << 5); R = (st >> 1) * 16 + swz / 64; C = (st & 1) * 32 + (swz % 64) / 2; }
__host__ __device__ __forceinline__ int perm32(int rho) { const int n = rho >> 4, i = rho & 15; return 8 * (i >> 2) + 4 * n + (i & 3); }

struct Unit { int pm, pn; };
struct Gemm { const bf16_t* A; const bf16_t* Bt; int M, N, K; };

struct StaticOrder {
    int nM, nN, nwg, G, c;
    __host__ __device__ void init(int M, int N, int G_, int c_) { nM = M / BM; nN = N / BM; nwg = nM * nN; G = G_; c = c_; }
    __host__ __device__ bool next(int i, Unit& u) const {
        const long L = (long)i * G + c; if (L >= nwg) return false;
        int wgid = (int)L; { const int q = nwg / NXCD, r = nwg % NXCD, xcd = wgid % NXCD, off = wgid / NXCD; wgid = (xcd < r ? xcd * (q + 1) : r * (q + 1) + (xcd - r) * q) + off; }
        const int nig = WGM * nN, gid = wgid / nig, fm = gid * WGM, gsz = (nM - fm) < WGM ? (nM - fm) : WGM;
        u.pm = fm + ((wgid % nig) % gsz); u.pn = (wgid % nig) / gsz; return true;
    }
    __device__ __forceinline__ void a_ready(const Unit&) const {}
    __device__ __forceinline__ void done(const Unit&) const {}
};
__device__ __forceinline__ unsigned cvt_pk_bf16(float lo, float hi) { unsigned r; asm volatile("v_cvt_pk_bf16_f32 %0, %1, %2" : "=v"(r) : "v"(lo), "v"(hi)); return r; }
typedef float f32x2 __attribute__((ext_vector_type(2)));
__device__ __forceinline__ f32x2 gelu_pk(f32x2 v) {
    const f32x2 av = __builtin_elementwise_abs(v), d = av * 0.2316418882f + 1.0f;
    f32x2 t; t.x = __builtin_amdgcn_rcpf(d.x); t.y = __builtin_amdgcn_rcpf(d.y);
    f32x2 q = t * 0.5307027145f + (-0.7265760135f); q = q * t + 0.7107068705f; q = q * t + (-0.142248368f); q = q * t + 0.127414796f; q = q * t;
    const f32x2 s = (v * v) * (-0.72134752044f);
    f32x2 e; e.x = __builtin_amdgcn_exp2f(s.x); e.y = __builtin_amdgcn_exp2f(s.y);
    const f32x2 m = v * (q * e), r = v - m;
    f32x2 o; o.x = v.x < 0.f ? m.x : r.x; o.y = v.y < 0.f ? m.y : r.y; return o;
}

struct EpiF32 {
    static constexpr bool PERM = false, AFTER_DRAIN = false;
    float* C; int ldc; const float* bias;
    __device__ __forceinline__ void operator()(const f32x4 (&acc)[2][2][4][2], const Unit& u, int wr, int wc, int fr, int fq) const {
        const int row0 = u.pm * BM + wr * 64 + fr, col0 = u.pn * BM + wc * 32 + 4 * fq;
        f32x4 bv[2][2];
#pragma unroll
        for (int bj = 0; bj < 2; ++bj)
#pragma unroll
            for (int n = 0; n < 2; ++n) bv[bj][n] = bias ? *(const f32x4*)(bias + col0 + bj * HALF + n * 16) : (f32x4){0.f, 0.f, 0.f, 0.f};
#pragma unroll
        for (int ai = 0; ai < 2; ++ai)
#pragma unroll
            for (int m = 0; m < 4; ++m) { float* rowp = C + (size_t)(row0 + ai * HALF + m * 16) * ldc + col0;
#pragma unroll
                for (int bj = 0; bj < 2; ++bj)
#pragma unroll
                    for (int n = 0; n < 2; ++n) *(f32x4*)(rowp + bj * HALF + n * 16) = acc[ai][bj][m][n] + bv[bj][n]; }
    }
};
struct PanelStats {
    unsigned* xbuf;
    unsigned* cnt;
    unsigned* tmo;
    int ntn; float eps;
    unsigned code;
    __device__ __forceinline__ bool run(const f32x4 (&v)[2][2][4][2], const Unit& u, int wr, int wc, int fr, int fq, PG8_LAS unsigned char* lds, int wid, int lane) const {
        typedef float f32x2v __attribute__((ext_vector_type(2)));
        PG8_LAS f32x2v* P = (PG8_LAS f32x2v*)lds;
        PG8_LAS f32x2v* S = (PG8_LAS f32x2v*)(lds + 8192);
        PG8_LAS unsigned* flag = (PG8_LAS unsigned*)(lds + 8192 + 2048);
#pragma unroll
        for (int ai = 0; ai < 2; ++ai)
#pragma unroll
            for (int m = 0; m < 4; ++m) {
                float s = 0.f;
#pragma unroll
                for (int bj = 0; bj < 2; ++bj)
#pragma unroll
                    for (int n = 0; n < 2; ++n) { const f32x4 x = v[ai][bj][m][n]; s += (x[0] + x[1]) + (x[2] + x[3]); }
                s += __shfl_xor(s, 16); s += __shfl_xor(s, 32);
                const float mw = s * (1.0f / 64.0f); float q = 0.f;
#pragma unroll
                for (int bj = 0; bj < 2; ++bj)
#pragma unroll
                    for (int n = 0; n < 2; ++n) { const f32x4 d = v[ai][bj][m][n] - mw; q += (d[0] * d[0] + d[1] * d[1]) + (d[2] * d[2] + d[3] * d[3]); }
                q += __shfl_xor(q, 16); q += __shfl_xor(q, 32);
                if (fq == 0) P[(ai * HALF + wr * 64 + m * 16 + fr) * 4 + wc] = (f32x2v){mw, q};
            }
        asm volatile("s_waitcnt lgkmcnt(0)" ::: "memory"); __builtin_amdgcn_s_barrier(); asm volatile("" ::: "memory");
#if defined(BROKEN_NO_WAIT)
        if (blockIdx.x >= 64) { const long long t0 = clock64(); while (clock64() - t0 < 60000) __builtin_amdgcn_s_sleep(8); }
#endif
        const int row = wid * 32 + (lane & 31);
        if (lane < 32) {
            const f32x2v a = P[row * 4 + 0], b = P[row * 4 + 1], c = P[row * 4 + 2], d = P[row * 4 + 3];
            const float mt = (a.x + b.x + c.x + d.x) * 0.25f;
            const float da = a.x - mt, db = b.x - mt, dc = c.x - mt, dd = d.x - mt;
            const float m2 = (a.y + b.y) + (c.y + d.y) + 64.0f * ((da * da + db * db) + (dc * dc + dd * dd));
            unsigned long long* slot = (unsigned long long*)xbuf + ((size_t)(u.pm * BM + row) * 4 + u.pn);
            __hip_atomic_store(slot, ((unsigned long long)__float_as_uint(m2) << 32) | __float_as_uint(mt), __ATOMIC_RELAXED, __HIP_MEMORY_SCOPE_AGENT);
        }
        asm volatile("s_waitcnt vmcnt(0)" ::: "memory");
        if (lane == 0) __hip_atomic_fetch_add(cnt + 64 * u.pm, 1u, __ATOMIC_RELAXED, __HIP_MEMORY_SCOPE_AGENT);
        if (wid == 0) {
            bool dead = false; const unsigned long long t0 = __builtin_amdgcn_s_memrealtime(); const unsigned want = 8u * (unsigned)ntn;
            for (;;) {
#if defined(BROKEN_NO_WAIT)
                break;
#endif
                if ((unsigned)__builtin_amdgcn_readfirstlane(__hip_atomic_load(cnt + 64 * u.pm, __ATOMIC_RELAXED, __HIP_MEMORY_SCOPE_AGENT)) >= want) break;
                if (__builtin_amdgcn_s_memrealtime() - t0 > 2000000ull) {
                    if (lane == 0) { unsigned expect = 0u; __hip_atomic_compare_exchange_strong(tmo + 1, &expect, code | (unsigned)(u.pm & 0xff), __ATOMIC_RELAXED, __ATOMIC_RELAXED, __HIP_MEMORY_SCOPE_AGENT);
                                     __hip_atomic_store(tmo, 1u, __ATOMIC_RELAXED, __HIP_MEMORY_SCOPE_AGENT); }
                    dead = true; break; }
                __builtin_amdgcn_s_sleep(2);
            }
            __builtin_amdgcn_fence(__ATOMIC_ACQUIRE, "agent");
            if (lane == 0) flag[0] = dead ? 1u : 0u;
        }
        asm volatile("s_waitcnt vmcnt(0) lgkmcnt(0)" ::: "memory"); __builtin_amdgcn_s_barrier(); asm volatile("" ::: "memory");
        const bool bad = flag[0] != 0u;
        if (lane < 32) {
            const unsigned long long* slot = (const unsigned long long*)xbuf + (size_t)(u.pm * BM + row) * 4; float mt[4], m2[4]; float ms = 0.f;
#pragma unroll
            for (int t = 0; t < 4; ++t) { if (t < ntn) { const unsigned long long w = __hip_atomic_load(slot + t, __ATOMIC_RELAXED, __HIP_MEMORY_SCOPE_AGENT); mt[t] = __uint_as_float((unsigned)w); m2[t] = __uint_as_float((unsigned)(w >> 32)); } else { mt[t] = 0.f; m2[t] = 0.f; } ms += mt[t]; }
            const float mean = ms / (float)ntn; float q = 0.f;
#pragma unroll
            for (int t = 0; t < 4; ++t) if (t < ntn) { const float dm = mt[t] - mean; q += m2[t] + 256.0f * dm * dm; }
            S[row] = (f32x2v){mean, 1.0f / sqrtf(q / (256.0f * (float)ntn) + eps)};
        }
        asm volatile("s_waitcnt lgkmcnt(0)" ::: "memory"); __builtin_amdgcn_s_barrier(); asm volatile("" ::: "memory");
        return bad;
    }
};
template <class Epi, class Sched, bool STAMP = false>
__device__ __forceinline__ void gemm_phase(PG8_LAS unsigned char* lds, const Gemm g, const Sched& S, const Epi& E, unsigned long long* stamps) {
    const int tid = threadIdx.x, wid = __builtin_amdgcn_readfirstlane(tid >> 6), lane = tid & 63, wr = wid >> 2, wc = wid & 3, fr = lane & 15, fq = lane >> 4;
    const int K = g.K, nt = K / BK;
    int ts_lo = 0, ts_hi = 0, nts = 0; const unsigned long long rt_entry = STAMP ? (unsigned long long)wall_clock64() : 0ull;
#define PG8_STAMP() do { if (STAMP && wid == 0 && nts < 64) { const unsigned long long _c = (unsigned long long)clock64(); \
        ts_lo = (lane == nts) ? (int)(unsigned)_c : ts_lo; ts_hi = (lane == nts) ? (int)(unsigned)(_c >> 32) : ts_hi; ++nts; } } while (0)
    PG8_STAMP();
    unsigned voffA[2], voffB[2];
#pragma unroll
    for (int i = 0; i < 2; ++i) { int R, C; stage_rc(tid * 16 + i * 8192, R, C); const int Rb = Epi::PERM ? ((R & ~31) + perm32(R & 31)) : R;
        voffA[i] = (unsigned)(R * K + C) * 2u; voffB[i] = (unsigned)(Rb * K + C) * 2u; }
    const size_t kstep = (size_t)(BK * 2);
    const size_t hstep = (size_t)HALF * K * 2;
    const size_t tstep = 2 * hstep;
    const unsigned ldsw = (unsigned)wid * 1024u;
    const int aoff = lds_byte(wr * 64 + fr, fq * 8), boff = lds_byte(wc * 32 + fr, fq * 8);
#define PG8_SA(b, h) (((b) * 2 + (h)) * HTB)
#define PG8_SB(b, h) ((4 + (b) * 2 + (h)) * HTB)
#define PG8_STAGE(bufoff, gbase, voff) do { _Pragma("unroll") for (int _i = 0; _i < 2; ++_i) \
        __builtin_amdgcn_global_load_lds((const unsigned*)((const char*)(gbase) + (voff)[_i]), (PG8_LAS unsigned*)(lds + (bufoff) + ldsw + _i * 8192), 16, 0, 0); } while (0)
#define PG8_LDA(dst, b, h) do { _Pragma("unroll") for (int m = 0; m < 4; ++m) _Pragma("unroll") for (int k = 0; k < 2; ++k) dst[m][k] = *(const PG8_LAS bf16x8*)(lds + PG8_SA(b, h) + aoff + m * 2048 + k * 1024); } while (0)
#define PG8_LDB(dst, b, h) do { _Pragma("unroll") for (int n = 0; n < 2; ++n) _Pragma("unroll") for (int k = 0; k < 2; ++k) dst[n][k] = *(const PG8_LAS bf16x8*)(lds + PG8_SB(b, h) + boff + n * 2048 + k * 1024); } while (0)
#define PG8_MMA(ai, bj, At, Bt) do { __builtin_amdgcn_s_setprio(1); _Pragma("unroll") for (int m = 0; m < 4; ++m) _Pragma("unroll") for (int n = 0; n < 2; ++n) _Pragma("unroll") for (int k = 0; k < 2; ++k) \
        acc[ai][bj][m][n] = __builtin_amdgcn_mfma_f32_16x16x32_bf16(Bt[n][k], At[m][k], acc[ai][bj][m][n], 0, 0, 0); __builtin_amdgcn_s_setprio(0); } while (0)
#define PG8_WAIT_V(n) asm volatile("s_waitcnt vmcnt(" #n ")" ::: "memory")
#define PG8_WAIT_L(n) asm volatile("s_waitcnt lgkmcnt(" #n ")" ::: "memory")
#define PG8_BAR __builtin_amdgcn_s_barrier()
#define PG8_SCHED __builtin_amdgcn_sched_barrier(0)
    Unit cur, nxt; int ui = 0;
    if (!S.next(0, cur)) return;
    f32x4 acc[2][2][4][2];
#pragma unroll
    for (int a = 0; a < 2; ++a)
#pragma unroll
        for (int b = 0; b < 2; ++b)
#pragma unroll
            for (int m = 0; m < 4; ++m)
#pragma unroll
                for (int n = 0; n < 2; ++n) acc[a][b][m][n] = (f32x4){0.f, 0.f, 0.f, 0.f};
    bf16x8 At[4][2], B0[2][2], B1[2][2];
    const char* cA = (const char*)g.A + (size_t)cur.pm * tstep; const char* cB = (const char*)g.Bt + (size_t)cur.pn * tstep;
    S.a_ready(cur);
    PG8_STAGE(PG8_SB(0, 0), cB, voffB); PG8_STAGE(PG8_SA(0, 0), cA, voffA); PG8_STAGE(PG8_SB(0, 1), cB + hstep, voffB); PG8_STAGE(PG8_SA(0, 1), cA + hstep, voffA);
    if (wr == 1) PG8_BAR;
    PG8_WAIT_V(4); PG8_BAR;
    PG8_STAGE(PG8_SB(1, 0), cB + kstep, voffB); PG8_STAGE(PG8_SA(1, 0), cA + kstep, voffA); PG8_STAGE(PG8_SB(1, 1), cB + hstep + kstep, voffB);
    PG8_WAIT_V(6); PG8_BAR;
    PG8_STAMP();
    for (;;) {
        const bool has_next = S.next(ui + 1, nxt);
        const char* nA = has_next ? (const char*)g.A + (size_t)nxt.pm * tstep : cA; const char* nB = has_next ? (const char*)g.Bt + (size_t)nxt.pn * tstep : cB;
        for (int t = 0; t < nt; t += 2) {
            const bool last = (t == nt - 2);
            const char* a1 = cA + (size_t)(t + 1) * kstep;
            const char* a2 = last ? nA : cA + (size_t)(t + 2) * kstep; const char* b2 = last ? nB : cB + (size_t)(t + 2) * kstep;
            const char* a3 = a2 + kstep; const char* b3 = b2 + kstep;
            if (last && has_next) S.a_ready(nxt);
            PG8_LDB(B0, 0, 0); PG8_SCHED; PG8_LDA(At, 0, 0); PG8_STAGE(PG8_SA(1, 1), a1 + hstep, voffA);
            PG8_WAIT_L(8); PG8_BAR; PG8_WAIT_L(0); PG8_MMA(0, 0, At, B0); PG8_BAR; PG8_SCHED;
            PG8_LDB(B1, 0, 1); PG8_STAGE(PG8_SB(0, 0), b2, voffB);
            PG8_BAR; PG8_WAIT_L(0); PG8_MMA(0, 1, At, B1); PG8_BAR;
            PG8_LDA(At, 0, 1); PG8_STAGE(PG8_SA(0, 0), a2, voffA);
            PG8_BAR; PG8_WAIT_L(0); PG8_MMA(1, 0, At, B0); PG8_BAR; PG8_SCHED;
            PG8_STAGE(PG8_SB(0, 1), b2 + hstep, voffB);
            PG8_WAIT_V(6); PG8_BAR; PG8_MMA(1, 1, At, B1); PG8_BAR;
            PG8_LDB(B0, 1, 0); PG8_SCHED; PG8_LDA(At, 1, 0); PG8_STAGE(PG8_SA(0, 1), a2 + hstep, voffA);
            PG8_WAIT_L(8); PG8_BAR; PG8_WAIT_L(0); PG8_MMA(0, 0, At, B0); PG8_BAR; PG8_SCHED;
            PG8_LDB(B1, 1, 1); PG8_STAGE(PG8_SB(1, 0), b3, voffB);
            PG8_BAR; PG8_WAIT_L(0); PG8_MMA(0, 1, At, B1); PG8_BAR;
            PG8_LDA(At, 1, 1); PG8_STAGE(PG8_SA(1, 0), a3, voffA);
            PG8_BAR; PG8_WAIT_L(0); PG8_MMA(1, 0, At, B0); PG8_BAR; PG8_SCHED;
            PG8_STAGE(PG8_SB(1, 1), b3 + hstep, voffB);
            PG8_WAIT_V(6); PG8_BAR; PG8_MMA(1, 1, At, B1); PG8_BAR;
        }
        PG8_STAMP();
        if constexpr (!Epi::AFTER_DRAIN) { E(acc, cur, wr, wc, fr, fq); S.done(cur); }
        PG8_STAMP();
        if (!has_next) break;
#pragma unroll
        for (int a = 0; a < 2; ++a)
#pragma unroll
            for (int b = 0; b < 2; ++b)
#pragma unroll
                for (int m = 0; m < 4; ++m)
#pragma unroll
                    for (int n = 0; n < 2; ++n) acc[a][b][m][n] = (f32x4){0.f, 0.f, 0.f, 0.f};
        cur = nxt; cA = nA; cB = nB; ++ui;
    }
    PG8_WAIT_V(0);
    if (wr == 0) PG8_BAR;
    PG8_BAR;
    if constexpr (Epi::AFTER_DRAIN) { E.fused(acc, cur, wr, wc, fr, fq, lds, wid, lane); S.done(cur); }
    PG8_STAMP();
    if (STAMP && wid == 0) { stamps[lane] = lane < nts ? (((unsigned long long)(unsigned)ts_hi << 32) | (unsigned)ts_lo) : 0ull;
        if (lane == 62) stamps[62] = rt_entry; if (lane == 63) stamps[63] = (unsigned long long)wall_clock64(); }
#undef PG8_STAMP
#undef PG8_SA
#undef PG8_SB
#undef PG8_STAGE
#undef PG8_LDA
#undef PG8_LDB
#undef PG8_MMA
#undef PG8_WAIT_V
#undef PG8_WAIT_L
#undef PG8_BAR
#undef PG8_SCHED
}
}
using pg8::bf16_t; using pg8::f32x4; using pg8::u32x4; using pg8::Unit;
typedef unsigned u32x2 __attribute__((ext_vector_type(2)));
#define LAS3 __attribute__((address_space(3)))

constexpr int DM = 1024, NPR = 16384, NSR = 1024, MT = 17408, HN = 3584, N1 = 3840, FF = 2816, NGU = 5632;
constexpr float DN_ALPHA = 1.189207115002721f;
constexpr size_t O_Y = 0, O_GLA_P = 17825792, O_GDN_P = 18087936, O_CONV_P = 18612224, O_GLA_S = 18649088, O_GDN_S = 22843392, O_CONV_S = 31232000;
constexpr size_t WS_CTL = 0, WS_WIN = 4096, WS_WOUT = WS_WIN + (size_t)N1 * DM * 2, WS_WGU = WS_WOUT + (size_t)DM * DM * 2, WS_WD = WS_WGU + (size_t)NGU * DM * 2,
                 WS_A = WS_WD + (size_t)DM * FF * 2, WS_H = WS_A + (size_t)MT * DM * 2, WS_P = WS_H + (size_t)MT * HN * 2,
                 WS_QKV = WS_P, WS_LA = WS_QKV + (size_t)MT * 1536 * 2, WS_GB = WS_LA + (size_t)MT * 256 * 4, WS_HS = WS_GB + (size_t)MT * 8 * 4, WS_END = WS_HS + (size_t)MT * 32 * 4,
                 WS_LAS = WS_END, WS_DV = WS_LAS + (size_t)NSR * 256 * 4, WS_GC = WS_DV + (size_t)1024 * 64 * 4, WS_END2 = WS_GC + (size_t)1024 * 64 * 4,
                 WS_GU = WS_LA,
                 WS_X1F = WS_H, WS_HID = WS_H + (size_t)MT * DM * 4;
constexpr size_t OB_M = 0, OB_N = (size_t)1024 * 16384 * 2;
static_assert(WS_HID + (size_t)MT * FF * 2 <= WS_END, "hid fits");

struct Params {
    const float *xp, *xs, *sgla, *sgdn, *sconv, *w_in, *wup, *bgate, *gla_ng, *convw, *alog, *dtb, *gdn_ng, *w_out, *ln1g, *ln1b, *wg, *wu, *wd, *ln2g, *ln2b;
    float* out; unsigned char* ws; int lo, hi;
};

__device__ __forceinline__ unsigned pk2(float lo, float hi) { return pg8::cvt_pk_bf16(lo, hi); }
__device__ __forceinline__ float bf2f(bf16_t b) { return __uint_as_float((unsigned)b << 16); }
__device__ __forceinline__ float bflo(unsigned w) { return __uint_as_float(w << 16); }
__device__ __forceinline__ float bfhi(unsigned w) { return __uint_as_float(w & 0xffff0000u); }
__device__ __forceinline__ float wave_sum(float v) {
#pragma unroll
    for (int o = 1; o < 64; o <<= 1) v += __shfl_xor(v, o);
    return v;
}
__device__ __forceinline__ float silu_f(float x) { return x / (1.0f + __expf(-x)); }

struct EpiH {
    static constexpr bool PERM = true, AFTER_DRAIN = false;
    bf16_t* H; float* HS;
    __device__ __forceinline__ void operator()(const f32x4 (&acc)[2][2][4][2], const Unit& u, int wr, int wc, int fr, int fq) const {
        const int row0 = u.pm * 256 + wr * 64 + fr;
        if (u.pn < 14) {
            const int col0 = u.pn * 256 + wc * 32 + 8 * fq;
#pragma unroll
            for (int ai = 0; ai < 2; ++ai)
#pragma unroll
                for (int m = 0; m < 4; ++m) { bf16_t* rowp = H + (size_t)(row0 + ai * 128 + m * 16) * HN + col0;
#pragma unroll
                    for (int bj = 0; bj < 2; ++bj) { const f32x4 v0 = acc[ai][bj][m][0], v1 = acc[ai][bj][m][1];
                        u32x4 w; w.x = pk2(v0[0], v0[1]); w.y = pk2(v0[2], v0[3]); w.z = pk2(v1[0], v1[1]); w.w = pk2(v1[2], v1[3]);
                        *(u32x4*)(rowp + bj * 128) = w; } }
        } else if (wc == 0) {
#pragma unroll
            for (int ai = 0; ai < 2; ++ai)
#pragma unroll
                for (int m = 0; m < 4; ++m) { float* rowp = HS + (size_t)(row0 + ai * 128 + m * 16) * 32 + 8 * fq;
                    *(f32x4*)rowp = acc[ai][0][m][0]; *(f32x4*)(rowp + 4) = acc[ai][0][m][1]; }
        }
    }
};
struct EpiSwiGLU {
    static constexpr bool PERM = true, AFTER_DRAIN = false;
    bf16_t* O;
    __device__ __forceinline__ void operator()(const f32x4 (&acc)[2][2][4][2], const Unit& u, int wr, int wc, int fr, int fq) const {
        const int row0 = u.pm * 256 + wr * 64 + fr, col0 = u.pn * 128 + wc * 32 + 8 * fq;
#pragma unroll
        for (int ai = 0; ai < 2; ++ai)
#pragma unroll
            for (int m = 0; m < 4; ++m) { bf16_t* rowp = O + (size_t)(row0 + ai * 128 + m * 16) * FF + col0;
                f32x4 r0, r1;
#pragma unroll
                for (int j = 0; j < 4; ++j) { r0[j] = silu_f(acc[ai][0][m][0][j]) * acc[ai][1][m][0][j]; r1[j] = silu_f(acc[ai][0][m][1][j]) * acc[ai][1][m][1][j]; }
                u32x4 w; w.x = pk2(r0[0], r0[1]); w.y = pk2(r0[2], r0[3]); w.z = pk2(r1[0], r1[1]); w.w = pk2(r1[2], r1[3]);
                *(u32x4*)rowp = w; }
    }
};

__device__ __forceinline__ int map_win(int r) { return r < 1536 ? r : (r < 3584 ? r + 16 : (r < 3600 ? 1536 + (r - 3584) : (r < 3608 ? r : -1))); }
template <int WHICH>
__device__ __forceinline__ void transpose_item(const Params& P, float* scr, int item, int lane) {
    constexpr int K = (WHICH == 3) ? FF : DM;
    constexpr int NDST = (WHICH == 0) ? N1 : (WHICH == 2 ? NGU : DM);
    constexpr int NSRC = (WHICH == 0) ? 3608 : (WHICH == 2 ? FF : DM);
    constexpr int nblk = NDST / 32;
    const int kb = item / nblk, nb = item % nblk, k0 = 64 * kb, n0 = 32 * nb;
    const int r = n0 + (lane & 31);
    const float* W; int sc;
    if (WHICH == 0) { W = P.w_in; sc = map_win(r); }
    else if (WHICH == 1) { W = P.w_out; sc = r; }
    else if (WHICH == 2) { const int pn = r >> 8, wi = r & 255; W = (wi < 128) ? P.wg : P.wu; sc = pn * 128 + (wi & 127); }
    else { W = P.wd; sc = r; }
    bf16_t* WT = (bf16_t*)(P.ws + (WHICH == 0 ? WS_WIN : WHICH == 1 ? WS_WOUT : WHICH == 2 ? WS_WGU : WS_WD));
#pragma unroll 8
    for (int i = 0; i < 32; ++i) { const int kk = 2 * i + (lane >> 5); scr[kk * 33 + (lane & 31)] = sc >= 0 ? W[(size_t)(k0 + kk) * NSRC + sc] : 0.f; }
    __builtin_amdgcn_s_waitcnt(0xc07f); asm volatile("" ::: "memory");
    const int c = lane & 7;
#pragma unroll
    for (int j = 0; j < 4; ++j) { const int n = (lane >> 3) + 8 * j; const float* s = scr + (8 * c) * 33 + n;
        u32x4 o; o.x = pk2(s[0 * 33], s[1 * 33]); o.y = pk2(s[2 * 33], s[3 * 33]); o.z = pk2(s[4 * 33], s[5 * 33]); o.w = pk2(s[6 * 33], s[7 * 33]);
        *(u32x4*)(WT + (size_t)(n0 + n) * K + k0 + 8 * c) = o; }
    __builtin_amdgcn_s_waitcnt(0xc07f); asm volatile("" ::: "memory");
}
__device__ __forceinline__ void phase_convert(const Params& P, unsigned char* lds) {
    const int tid = threadIdx.x, lane = tid & 63, wave = tid >> 6, gw = blockIdx.x * 8 + wave, NGW = gridDim.x * 8;
    float* scr = (float*)lds + wave * (64 * 33);
    constexpr int I0 = (DM / 64) * (N1 / 32), I1 = (DM / 64) * (DM / 32), I2 = (DM / 64) * (NGU / 32), I3 = (FF / 64) * (DM / 32);
    for (int it = gw; it < I0 + I1 + I2 + I3; it += NGW) {
        int r = it;
        if (r < I0) { transpose_item<0>(P, scr, r, lane); continue; } r -= I0;
        if (r < I1) { transpose_item<1>(P, scr, r, lane); continue; } r -= I1;
        if (r < I2) { transpose_item<2>(P, scr, r, lane); continue; } r -= I2;
        transpose_item<3>(P, scr, r, lane);
    }
    bf16_t* XB = (bf16_t*)(P.ws + WS_A);
    for (int row = gw; row < MT; row += NGW) {
        const float* src = row < NPR ? P.xp + (size_t)row * DM : P.xs + (size_t)(row - NPR) * DM;
#pragma unroll
        for (int j = 0; j < 4; ++j) { const f32x4 v = *(const f32x4*)(src + lane * 4 + 256 * j); u32x2 w; w.x = pk2(v[0], v[1]); w.y = pk2(v[2], v[3]);
            *(u32x2*)(XB + (size_t)row * DM + lane * 4 + 256 * j) = w; }
    }
}

__device__ __forceinline__ float log_sigmoid_f(float z) { return fminf(z, 0.f) - log1pf(expf(-fabsf(z))); }
__device__ __forceinline__ float softplus_f(float z) { return fmaxf(z, 0.f) + log1pf(expf(-fabsf(z))); }
__device__ __forceinline__ void phase_prep(const Params& P) {
    const int tid = threadIdx.x, lane = tid & 63, wave = tid >> 6, gw = blockIdx.x * 8 + wave, NGW = gridDim.x * 8;
    const bf16_t* H = (const bf16_t*)(P.ws + WS_H); const float* HS = (const float*)(P.ws + WS_HS);
    float* LA = (float*)(P.ws + WS_LAS); float* GB = (float*)(P.ws + WS_GB); bf16_t* QKV = (bf16_t*)(P.ws + WS_QKV);
    {
        f32x4 wv[16];
#pragma unroll
        for (int r = 0; r < 16; ++r) wv[r] = *(const f32x4*)(P.wup + r * 256 + lane * 4);
        const f32x4 bias = *(const f32x4*)(P.bgate + lane * 4);
        const float na = (lane < 4) ? -expf(P.alog[lane]) : 0.f, dtb = (lane < 4) ? P.dtb[lane] : 0.f;
        for (int row = gw; row < MT; row += NGW) {
            const float* hsr = HS + (size_t)row * 32;
            f32x4 z = bias;
#pragma unroll
            for (int r4 = 0; r4 < 4; ++r4) { const f32x4 g4 = *(const f32x4*)(hsr + 4 * r4);
#pragma unroll
                for (int j = 0; j < 4; ++j) z += g4[j] * wv[r4 * 4 + j]; }
            f32x4 la;
#pragma unroll
            for (int j = 0; j < 4; ++j) la[j] = log_sigmoid_f(z[j]) * (1.0f / 16.0f);
            if (row >= NPR) *(f32x4*)(LA + (size_t)(row - NPR) * 256 + lane * 4) = la;
            if (lane < 4) { const float da = hsr[16 + lane], db = hsr[20 + lane];
                GB[(size_t)row * 8 + lane] = na * softplus_f(da + dtb); GB[(size_t)row * 8 + 4 + lane] = 1.0f / (1.0f + expf(-db)); }
        }
    }
    for (int w = gw; w < (MT / 8) * 12; w += NGW) {
        const int tile = w / 12, gi = w % 12, r0 = tile * 8, cb = gi * 128 + 2 * lane;
        const bool prompt = r0 < NPR; const bool seq_start = prompt ? ((r0 & 2047) == 0) : true;
        const int bs = prompt ? (r0 >> 11) : ((r0 - NPR) >> 3);
        float x0[11], x1[11];
#pragma unroll
        for (int j = 0; j < 11; ++j) {
            if (j >= 3 || !seq_start) { const unsigned wd = *(const unsigned*)(H + (size_t)(r0 - 3 + j) * HN + 1536 + cb); x0[j] = bflo(wd); x1[j] = bfhi(wd); }
            else if (prompt) { x0[j] = 0.f; x1[j] = 0.f; }
            else { const float* s = P.sconv + ((size_t)bs * 3 + j) * 1536 + cb; x0[j] = s[0]; x1[j] = s[1]; }
        }
        float c0w[4], c1w[4];
#pragma unroll
        for (int i = 0; i < 4; ++i) { c0w[i] = P.convw[i * 1536 + cb]; c1w[i] = P.convw[i * 1536 + cb + 1]; }
#pragma unroll
        for (int t = 0; t < 8; ++t) {
            float c0 = 0.f, c1 = 0.f;
#pragma unroll
            for (int i = 0; i < 4; ++i) { c0 += c0w[i] * x0[t + i]; c1 += c1w[i] * x1[t + i]; }
            c0 = silu_f(c0); c1 = silu_f(c1);
            if (gi < 8) { const float ss = wave_sum(c0 * c0 + c1 * c1); const float sc = rsqrtf(ss + 1e-6f) * (gi < 4 ? 0.08838834764831845f : 1.0f); c0 *= sc; c1 *= sc; }
            *(unsigned*)(QKV + (size_t)(r0 + t) * 1536 + cb) = pk2(c0, c1);
        }
        if (prompt) { if ((r0 & 2047) == 2040) {
#pragma unroll
                for (int j = 0; j < 3; ++j) { float* o = P.out + O_CONV_P + ((size_t)bs * 3 + j) * 1536 + cb; o[0] = x0[8 + j]; o[1] = x1[8 + j]; } } }
        else {
#pragma unroll
            for (int j = 0; j < 3; ++j) { float* o = P.out + O_CONV_S + ((size_t)bs * 3 + j) * 1536 + cb; o[0] = x0[8 + j]; o[1] = x1[8 + j]; } }
    }
}

__device__ __forceinline__ void unpack16_to_lds(float* dst, const u32x4& a, const u32x4& c) {
    *(f32x4*)(dst + 0) = (f32x4){bflo(a.x), bfhi(a.x), bflo(a.y), bfhi(a.y)}; *(f32x4*)(dst + 4) = (f32x4){bflo(a.z), bfhi(a.z), bflo(a.w), bfhi(a.w)};
    *(f32x4*)(dst + 8) = (f32x4){bflo(c.x), bfhi(c.x), bflo(c.y), bfhi(c.y)}; *(f32x4*)(dst + 12) = (f32x4){bflo(c.z), bfhi(c.z), bflo(c.w), bfhi(c.w)};
}
__device__ __forceinline__ void rec_gdn(const Params& P, float* lds, int seq) {
    const int tid = threadIdx.x, p = tid >> 7, v = tid & 127, wave = tid >> 6, lane = tid & 63;
    constexpr bool prompt = false; const int b = seq - 8; constexpr int T = 8;
    const size_t row0 = prompt ? (size_t)b * 2048 : (size_t)NPR + (size_t)b * 8;
    const bf16_t* QKV = (const bf16_t*)(P.ws + WS_QKV); const float* GB = (const float*)(P.ws + WS_GB); const bf16_t* H = (const bf16_t*)(P.ws + WS_H);
    bf16_t* OM = (bf16_t*)(P.ws + WS_A);
    float S[128];
    { const float* s0 = P.sgdn + ((size_t)(b * 4 + p) * 128) * 128 + v;
#pragma unroll
      for (int g16 = 0; g16 < 8; ++g16) {
#pragma unroll
          for (int d = 0; d < 16; ++d) S[16 * g16 + d] = s0[d * 128];
          s0 += 16 * 128; asm volatile("" : "+v"(s0) :: "memory"); } }
    float* qs = lds; float* ks = lds + 8 * 512; float* part = lds + 16 * 512; float* gbs = part + 16;
    const float ng = P.gdn_ng[v];
    for (int t0 = 0; t0 < T; t0 += 8) {
        __syncthreads();
        { const int tt = tid >> 6; const bf16_t* src = QKV + (row0 + t0 + tt) * 1536 + lane * 16; const u32x4 a = *(const u32x4*)src, c = *(const u32x4*)(src + 8);
          unpack16_to_lds((lane < 32 ? qs : ks) + tt * 512 + (lane & 31) * 16, a, c); }
        if (tid < 64) gbs[tid] = GB[(row0 + t0) * 8 + tid];
        float vv[8], gt[8];
#pragma unroll
        for (int tt = 0; tt < 8; ++tt) { const size_t row = row0 + t0 + tt;
            vv[tt] = bf2f(QKV[row * 1536 + 1024 + p * 128 + v]); gt[tt] = bf2f(H[row * HN + 3072 + p * 128 + v]); }
        __syncthreads();
#pragma unroll 1
        for (int tt = 0; tt < 8; ++tt) {
            const float a = __expf(gbs[tt * 8 + p]); const float beta = gbs[tt * 8 + 4 + p];
            const f32x4* kp = (const f32x4*)(ks + tt * 512 + p * 128); const f32x4* qp = (const f32x4*)(qs + tt * 512 + p * 128);
            float kS0 = 0.f, kS1 = 0.f;
#pragma unroll
            for (int g8 = 0; g8 < 4; ++g8) {
#pragma unroll
                for (int d4 = 8 * g8; d4 < 8 * g8 + 8; ++d4) { const f32x4 k4 = kp[d4]; kS0 += k4[0] * S[4 * d4] + k4[2] * S[4 * d4 + 2]; kS1 += k4[1] * S[4 * d4 + 1] + k4[3] * S[4 * d4 + 3]; }
                asm volatile("" ::: "memory"); }
            const float dl = beta * (vv[tt] - a * (kS0 + kS1));
            float o0 = 0.f, o1 = 0.f;
#pragma unroll
            for (int g8 = 0; g8 < 8; ++g8) {
#pragma unroll
                for (int d4 = 4 * g8; d4 < 4 * g8 + 4; ++d4) { const f32x4 k4 = kp[d4], q4 = qp[d4];
                    S[4 * d4] = a * S[4 * d4] + k4[0] * dl; S[4 * d4 + 1] = a * S[4 * d4 + 1] + k4[1] * dl; S[4 * d4 + 2] = a * S[4 * d4 + 2] + k4[2] * dl; S[4 * d4 + 3] = a * S[4 * d4 + 3] + k4[3] * dl;
                    o0 += q4[0] * S[4 * d4] + q4[2] * S[4 * d4 + 2]; o1 += q4[1] * S[4 * d4 + 1] + q4[3] * S[4 * d4 + 3]; }
                asm volatile("" ::: "memory"); }
            const float o = o0 + o1; const float ss = wave_sum(o * o);
            if (lane == 0) part[(tt & 1) * 8 + wave] = ss;
            __syncthreads();
            const float tot = part[(tt & 1) * 8 + 2 * p] + part[(tt & 1) * 8 + 2 * p + 1];
            const float r = rsqrtf(tot * (1.0f / 128.0f) + 1e-5f);
            const float val = o * r * ng * silu_f(gt[tt]);
            OM[(row0 + t0 + tt) * DM + 512 + p * 128 + v] = (bf16_t)(pk2(val, 0.f) & 0xffffu);
        }
    }
    float* so = P.out + O_GDN_S + ((size_t)(b * 4 + p) * 128) * 128 + v;
#pragma unroll
    for (int g16 = 0; g16 < 8; ++g16) {
#pragma unroll
        for (int d = 0; d < 16; ++d) so[d * 128] = S[16 * g16 + d];
        so += 16 * 128; asm volatile("" : "+v"(so) :: "memory"); }
}
__device__ __forceinline__ void rec_gla(const Params& P, float* lds, int seq) {
    const int tid = threadIdx.x, p = tid >> 7, v = tid & 127, wave = tid >> 6, lane = tid & 63;
    constexpr bool prompt = false; const int b = seq - 8; constexpr int T = 8;
    const size_t row0 = prompt ? (size_t)b * 2048 : (size_t)NPR + (size_t)b * 8;
    const float* LA = (const float*)(P.ws + WS_LAS) - (size_t)NPR * 256; const bf16_t* H = (const bf16_t*)(P.ws + WS_H);
    bf16_t* OM = (bf16_t*)(P.ws + WS_A);
    float S[64];
    if (prompt) {
#pragma unroll
        for (int d = 0; d < 64; ++d) S[d] = 0.f;
    } else { const float* s0 = P.sgla + ((size_t)(b * 4 + p) * 64) * 128 + v;
#pragma unroll
        for (int d = 0; d < 64; ++d) S[d] = s0[(size_t)d * 128]; }
    float* qs = lds; float* ks = lds + 8 * 256; float* as = lds + 16 * 256; float* part = lds + 24 * 256;
    const float ng = P.gla_ng[v];
    for (int t0 = 0; t0 < T; t0 += 8) {
        __syncthreads();
        { const int tt = tid >> 6; const size_t row = row0 + t0 + tt;
          const u32x2 qw = *(const u32x2*)(H + row * HN + lane * 4), kw = *(const u32x2*)(H + row * HN + 256 + lane * 4); const f32x4 la = *(const f32x4*)(LA + row * 256 + lane * 4);
          *(f32x4*)(qs + tt * 256 + lane * 4) = (f32x4){bflo(qw.x) * 0.125f, bfhi(qw.x) * 0.125f, bflo(qw.y) * 0.125f, bfhi(qw.y) * 0.125f};
          *(f32x4*)(ks + tt * 256 + lane * 4) = (f32x4){bflo(kw.x), bfhi(kw.x), bflo(kw.y), bfhi(kw.y)};
          *(f32x4*)(as + tt * 256 + lane * 4) = (f32x4){__expf(la[0]), __expf(la[1]), __expf(la[2]), __expf(la[3])}; }
        float vv[8], gt[8];
#pragma unroll
        for (int tt = 0; tt < 8; ++tt) { const size_t row = row0 + t0 + tt; vv[tt] = bf2f(H[row * HN + 512 + p * 128 + v]); gt[tt] = bf2f(H[row * HN + 1024 + p * 128 + v]); }
        __syncthreads();
#pragma unroll 1
        for (int tt = 0; tt < 8; ++tt) {
            const f32x4* kp = (const f32x4*)(ks + tt * 256 + p * 64); const f32x4* qp = (const f32x4*)(qs + tt * 256 + p * 64); const f32x4* ap = (const f32x4*)(as + tt * 256 + p * 64);
            const float vt = vv[tt]; float o0 = 0.f, o1 = 0.f;
#pragma unroll
            for (int g8 = 0; g8 < 4; ++g8) {
#pragma unroll
                for (int d4 = 4 * g8; d4 < 4 * g8 + 4; ++d4) { const f32x4 k4 = kp[d4], q4 = qp[d4], a4 = ap[d4];
                    S[4 * d4] = a4[0] * S[4 * d4] + k4[0] * vt; S[4 * d4 + 1] = a4[1] * S[4 * d4 + 1] + k4[1] * vt; S[4 * d4 + 2] = a4[2] * S[4 * d4 + 2] + k4[2] * vt; S[4 * d4 + 3] = a4[3] * S[4 * d4 + 3] + k4[3] * vt;
                    o0 += q4[0] * S[4 * d4] + q4[2] * S[4 * d4 + 2]; o1 += q4[1] * S[4 * d4 + 1] + q4[3] * S[4 * d4 + 3]; }
                asm volatile("" ::: "memory"); }
            const float o = o0 + o1; const float ss = wave_sum(o * o);
            if (lane == 0) part[(tt & 1) * 8 + wave] = ss;
            __syncthreads();
            const float tot = part[(tt & 1) * 8 + 2 * p] + part[(tt & 1) * 8 + 2 * p + 1];
            const float r = rsqrtf(tot * (1.0f / 128.0f) + 1e-5f);
            const float val = o * r * ng * silu_f(gt[tt]);
            OM[(row0 + t0 + tt) * DM + p * 128 + v] = (bf16_t)(pk2(val, 0.f) & 0xffffu);
        }
    }
    float* so = P.out + (prompt ? O_GLA_P : O_GLA_S) + ((size_t)(b * 4 + p) * 64) * 128 + v;
#pragma unroll
    for (int d = 0; d < 64; ++d) so[(size_t)d * 128] = S[d];
}

typedef pg8::bf16x8 bf16x8;
__device__ __forceinline__ f32x4 mma16(const bf16_t* A, int lda, const bf16_t* B, int ldb, int K, f32x4 acc, int lane) {
    const bf16_t* ap = A + (lane & 15) * lda + 8 * (lane >> 4); const bf16_t* bp = B + (lane & 15) * ldb + 8 * (lane >> 4);
    for (int k = 0; k < K; k += 32) acc = __builtin_amdgcn_mfma_f32_16x16x32_bf16(*(const bf16x8*)(ap + k), *(const bf16x8*)(bp + k), acc, 0, 0, 0);
    return acc;
}
__device__ __forceinline__ bf16_t f2bf(float x) { return (bf16_t)(pk2(x, 0.f) & 0xffffu); }
__device__ __forceinline__ bf16_t f2bf_sw(float x) { unsigned u = __float_as_uint(x); u += 0x7fffu + ((u >> 16) & 1u); return (bf16_t)(u >> 16); }
__device__ __forceinline__ void unpack8(const u32x4& a, float (&f)[8]) { f[0] = bflo(a.x); f[1] = bfhi(a.x); f[2] = bflo(a.y); f[3] = bfhi(a.y); f[4] = bflo(a.z); f[5] = bfhi(a.z); f[6] = bflo(a.w); f[7] = bfhi(a.w); }
__device__ __forceinline__ void mix_out(const f32x4 (&o)[4], int mt, int nh, float* ssq, const bf16_t* gate_base, bf16_t* out_base, const float* ng, int lane) {
    float ss[4];
#pragma unroll
    for (int r = 0; r < 4; ++r) { float a = 0.f;
#pragma unroll
        for (int q = 0; q < 4; ++q) a += o[q][r] * o[q][r];
        a += __shfl_xor(a, 1); a += __shfl_xor(a, 2); a += __shfl_xor(a, 4); a += __shfl_xor(a, 8); ss[r] = a; }
    if ((lane & 15) == 0) {
#pragma unroll
        for (int r = 0; r < 4; ++r) ssq[(16 * mt + 4 * (lane >> 4) + r) * 2 + nh] = ss[r]; }
    __syncthreads();
#pragma unroll
    for (int r = 0; r < 4; ++r) { const int t = 16 * mt + 4 * (lane >> 4) + r; const float rs = rsqrtf((ssq[2 * t] + ssq[2 * t + 1]) * (1.0f / 128.0f) + 1e-5f);
#pragma unroll
        for (int q = 0; q < 4; ++q) { const int v = (nh * 4 + q) * 16 + (lane & 15);
            out_base[(size_t)t * DM + v] = f2bf(o[q][r] * rs * ng[v] * silu_f(bf2f(gate_base[(size_t)t * HN + v]))); } }
}

__device__ __forceinline__ void gla_cumdecay(const Params& P, unsigned char* lds, size_t R0, int h) {
    const int tid = threadIdx.x;
    float* bcs = (float*)lds; float* seg = (float*)(lds + 16384); float* Wups = (float*)(lds + 18432); float* gas = (float*)(lds + 22528);
    const float* HS = (const float*)(P.ws + WS_HS);
    for (int i = tid; i < 1024; i += 512) { Wups[i] = P.wup[(i >> 6) * 256 + h * 64 + (i & 63)]; gas[i] = HS[(R0 + (i >> 4)) * 32 + (i & 15)]; }
    __syncthreads();
    { const int t = tid >> 3, dg = tid & 7; float z[8];
#pragma unroll
      for (int j = 0; j < 8; ++j) z[j] = P.bgate[h * 64 + dg * 8 + j];
#pragma unroll
      for (int r = 0; r < 16; ++r) { const float g = gas[t * 16 + r];
#pragma unroll
          for (int j = 0; j < 8; ++j) z[j] += g * Wups[r * 64 + dg * 8 + j]; }
#pragma unroll
      for (int j = 0; j < 8; ++j) bcs[t * 64 + dg * 8 + j] = log_sigmoid_f(z[j]) * (1.0f / 16.0f); }
    __syncthreads();
    { const int d = tid & 63, sg = tid >> 6; float v[8]; float run = 0.f;
#pragma unroll
      for (int i = 0; i < 8; ++i) { run += bcs[(8 * sg + i) * 64 + d]; v[i] = run; }
      seg[sg * 64 + d] = run;
      __syncthreads();
      float off = 0.f;
      for (int s2 = 0; s2 < sg; ++s2) off += seg[s2 * 64 + d];
#pragma unroll
      for (int i = 0; i < 8; ++i) bcs[(8 * sg + i) * 64 + d] = v[i] + off; }
    __syncthreads();
}
__device__ __forceinline__ void gla_load_vt(const bf16_t* H, bf16_t* VT, size_t R0, int h, int tid) {
    const int t = tid & 63, vg = tid >> 6; const bf16_t* src = H + (R0 + t) * HN + 512 + h * 128 + vg * 16;
    const u32x4 a = *(const u32x4*)src, c = *(const u32x4*)(src + 8); float f[8], g[8]; unpack8(a, f); unpack8(c, g);
#pragma unroll
    for (int j = 0; j < 8; ++j) { VT[(vg * 16 + j) * 72 + t] = f2bf(f[j]); VT[(vg * 16 + 8 + j) * 72 + t] = f2bf(g[j]); }
}
__device__ __forceinline__ void gla_a(const Params& P, unsigned char* lds, int task) {
    const int tid = threadIdx.x, lane = tid & 63, wave = tid >> 6; const int c = task & 31, bh = task >> 5, h = bh & 3, b = bh >> 2;
    const size_t R0 = (size_t)b * 2048 + c * 64;
    const bf16_t* H = (const bf16_t*)(P.ws + WS_H); float* bcs = (float*)lds; bf16_t* KdT = (bf16_t*)(lds + 26624); bf16_t* VT = (bf16_t*)(lds + 54272);
    gla_cumdecay(P, lds, R0, h);
    if (tid < 64) ((float*)(P.ws + WS_DV))[task * 64 + tid] = __expf(bcs[63 * 64 + tid]);
    { const int t = tid & 63, dg = tid >> 6; const u32x4 a = *(const u32x4*)(H + (R0 + t) * HN + 256 + h * 64 + dg * 8); float f[8]; unpack8(a, f);
#pragma unroll
      for (int j = 0; j < 8; ++j) { const int d = dg * 8 + j; KdT[d * 72 + t] = f2bf(f[j] * __expf(bcs[63 * 64 + d] - bcs[t * 64 + d])); } }
    gla_load_vt(H, VT, R0, h, tid);
    __syncthreads();
    bf16_t* GU = (bf16_t*)(P.ws + WS_GU) + (size_t)task * 8192;
    const int mt = wave >> 1, nh = wave & 1;
#pragma unroll
    for (int q = 0; q < 4; ++q) { const int nt = nh * 4 + q; const f32x4 acc = mma16(KdT + mt * 16 * 72, 72, VT + nt * 16 * 72, 72, 64, (f32x4){0.f, 0.f, 0.f, 0.f}, lane);
#pragma unroll
        for (int r = 0; r < 4; ++r) GU[(16 * mt + 4 * (lane >> 4) + r) * 128 + 16 * nt + (lane & 15)] = f2bf_sw(acc[r]); }
    __syncthreads();
}
__device__ __forceinline__ void gla_c(const Params& P, unsigned char* lds, int task) {
    const int tid = threadIdx.x, lane = tid & 63, wave = tid >> 6; const int c = task & 31, bh = task >> 5, h = bh & 3, b = bh >> 2;
    const size_t R0 = (size_t)b * 2048 + c * 64;
    const bf16_t* H = (const bf16_t*)(P.ws + WS_H); float* bcs = (float*)lds; bf16_t* Qt = (bf16_t*)(lds + 26624); bf16_t* Kt = (bf16_t*)(lds + 35840); bf16_t* At = (bf16_t*)(lds + 45056);
    bf16_t* VT = (bf16_t*)(lds + 54272); bf16_t* ScT = (bf16_t*)(lds + 72704); float* ssq = (float*)(lds + 91136);
    gla_cumdecay(P, lds, R0, h);
    { const int t = tid >> 3, dg = tid & 7; const u32x4 qa = *(const u32x4*)(H + (R0 + t) * HN + h * 64 + dg * 8), ka = *(const u32x4*)(H + (R0 + t) * HN + 256 + h * 64 + dg * 8);
      float qf[8], kf[8]; unpack8(qa, qf); unpack8(ka, kf);
#pragma unroll
      for (int j = 0; j < 8; ++j) { const float bb = bcs[t * 64 + dg * 8 + j]; qf[j] *= 0.125f * __expf(bb); kf[j] *= __expf(-bb); }
      u32x4 w; w.x = pk2(qf[0], qf[1]); w.y = pk2(qf[2], qf[3]); w.z = pk2(qf[4], qf[5]); w.w = pk2(qf[6], qf[7]); *(u32x4*)(Qt + t * 72 + dg * 8) = w;
      w.x = pk2(kf[0], kf[1]); w.y = pk2(kf[2], kf[3]); w.z = pk2(kf[4], kf[5]); w.w = pk2(kf[6], kf[7]); *(u32x4*)(Kt + t * 72 + dg * 8) = w; }
    gla_load_vt(H, VT, R0, h, tid);
    { const bf16_t* GU = (const bf16_t*)(P.ws + WS_GU) + (size_t)task * 8192; const int d = tid & 63, vg = tid >> 6;
      const u32x4 a = *(const u32x4*)(GU + d * 128 + vg * 16), c2 = *(const u32x4*)(GU + d * 128 + vg * 16 + 8); float f[8], g[8]; unpack8(a, f); unpack8(c2, g);
#pragma unroll
      for (int j = 0; j < 8; ++j) { ScT[(vg * 16 + j) * 72 + d] = f2bf(f[j]); ScT[(vg * 16 + 8 + j) * 72 + d] = f2bf(g[j]); } }
    __syncthreads();
#pragma unroll
    for (int k2 = 0; k2 < 2; ++k2) { const int id = 2 * wave + k2, mt = id >> 2, nt = id & 3;
        f32x4 acc = (f32x4){0.f, 0.f, 0.f, 0.f};
        if (nt <= mt) acc = mma16(Qt + mt * 16 * 72, 72, Kt + nt * 16 * 72, 72, 64, acc, lane);
#pragma unroll
        for (int r = 0; r < 4; ++r) { const int i = 16 * mt + 4 * (lane >> 4) + r, j = 16 * nt + (lane & 15); At[i * 72 + j] = f2bf_sw(j <= i ? acc[r] : 0.f); } }
    __syncthreads();
    const int mt = wave >> 1, nh = wave & 1; f32x4 o[4];
#pragma unroll
    for (int q = 0; q < 4; ++q) { const int nt = nh * 4 + q; o[q] = mma16(At + mt * 16 * 72, 72, VT + nt * 16 * 72, 72, 64, (f32x4){0.f, 0.f, 0.f, 0.f}, lane);
        o[q] = mma16(Qt + mt * 16 * 72, 72, ScT + nt * 16 * 72, 72, 64, o[q], lane); }
    mix_out(o, mt, nh, ssq, H + R0 * HN + 1024 + h * 128, (bf16_t*)(P.ws + WS_A) + R0 * DM + h * 128, P.gla_ng, lane);
    __syncthreads();
}

__device__ __forceinline__ void gdn_a(const Params& P, unsigned char* lds, int task) {
    const int tid = threadIdx.x, lane = tid & 63, wave = tid >> 6; const int c = task & 31, bh = task >> 5, h = bh & 3, b = bh >> 2;
    const size_t R0 = (size_t)b * 2048 + c * 64;
    const bf16_t* QKV = (const bf16_t*)(P.ws + WS_QKV); const float* GB = (const float*)(P.ws + WS_GB); bf16_t* H = (bf16_t*)(P.ws + WS_H);
    float* Am = (float*)lds; float* gcs = (float*)(lds + 16384); float* bts = gcs + 64; float* egs = gcs + 128;
    bf16_t* Ks = (bf16_t*)(lds + 17152); bf16_t* Qs = (bf16_t*)(lds + 34560); bf16_t* Vs = (bf16_t*)(lds + 51968);
    bf16_t* KdT = (bf16_t*)(lds + 69376); bf16_t* uT = (bf16_t*)(lds + 87808); bf16_t* wT = (bf16_t*)(lds + 106240);
    for (int i = tid; i < 3072; i += 512) { const int mat = i >> 10, t = (i & 1023) >> 4, ch = i & 15;
        *(u32x4*)((mat == 0 ? Qs : (mat == 1 ? Ks : Vs)) + t * 136 + ch * 8) = *(const u32x4*)(QKV + (R0 + t) * 1536 + mat * 512 + h * 128 + ch * 8); }
    if (wave == 0) { float x = GB[(R0 + lane) * 8 + h]; const float bt = GB[(R0 + lane) * 8 + 4 + h];
#pragma unroll
        for (int o = 1; o < 64; o <<= 1) { const float y = __shfl_up(x, o); if (lane >= o) x += y; }
        gcs[lane] = x; bts[lane] = bt; egs[lane] = __expf(x); ((float*)(P.ws + WS_GC))[task * 64 + lane] = x; }
    __syncthreads();
    const float glast = gcs[63];
    { const int t = tid & 63, dg = tid >> 6; const float sc = __expf(glast - gcs[t]);
      const u32x4 a = *(const u32x4*)(Ks + t * 136 + dg * 16), c2 = *(const u32x4*)(Ks + t * 136 + dg * 16 + 8); float f[8], g[8]; unpack8(a, f); unpack8(c2, g);
#pragma unroll
      for (int j = 0; j < 8; ++j) { KdT[(dg * 16 + j) * 72 + t] = f2bf(f[j] * sc); KdT[(dg * 16 + 8 + j) * 72 + t] = f2bf(g[j] * sc); } }
    { const int mt = wave & 3; const bool isq = wave >= 4; const bf16_t* Ap = (isq ? Qs : Ks) + mt * 16 * 136;
#pragma unroll
      for (int nt = 0; nt < 4; ++nt) { f32x4 acc = (f32x4){0.f, 0.f, 0.f, 0.f};
          if (nt <= mt) acc = mma16(Ap, 136, Ks + nt * 16 * 136, 136, 128, acc, lane);
#pragma unroll
          for (int r = 0; r < 4; ++r) { const int i = 16 * mt + 4 * (lane >> 4) + r, j = 16 * nt + (lane & 15); const float e = __expf(fminf(gcs[i] - gcs[j], 0.f));
              if (!isq) Am[i * 64 + j] = (j < i) ? bts[i] * acc[r] * e : 0.f;
              else H[(R0 + i) * HN + 2560 + h * 128 + j] = f2bf_sw(j <= i ? acc[r] * e : 0.f); } } }
    __syncthreads();
    if (tid < 256) {
        const bool isw = tid >= 128; const int cc = tid & 127; float x[64];
        const bf16_t* src = (isw ? Ks : Vs) + cc;
#pragma unroll
        for (int t8 = 0; t8 < 8; ++t8) {
#pragma unroll
            for (int t = 8 * t8; t < 8 * t8 + 8; ++t) x[t] = bf2f(src[t * 136]) * bts[t] * (isw ? egs[t] : 1.0f);
            asm volatile("" : "+v"(x[8 * t8 + 7]) :: "memory"); }
#pragma unroll
        for (int i = 1; i < 64; ++i) { float s0 = x[i], s1 = 0.f;
#pragma unroll
            for (int j4 = 0; j4 < (i + 3) / 4; ++j4) { const f32x4 a4 = *(const f32x4*)(Am + i * 64 + 4 * j4); s0 -= a4[0] * x[4 * j4] + a4[2] * x[4 * j4 + 2]; s1 -= a4[1] * x[4 * j4 + 1] + a4[3] * x[4 * j4 + 3]; }
            x[i] = s0 + s1; asm volatile("" : "+v"(x[i]) :: "memory"); }
        bf16_t* dT = (isw ? wT : uT) + cc * 72;
#pragma unroll
        for (int t8 = 0; t8 < 8; ++t8) { u32x4 w; w.x = pk2(x[8 * t8], x[8 * t8 + 1]); w.y = pk2(x[8 * t8 + 2], x[8 * t8 + 3]); w.z = pk2(x[8 * t8 + 4], x[8 * t8 + 5]); w.w = pk2(x[8 * t8 + 6], x[8 * t8 + 7]); *(u32x4*)(dT + 8 * t8) = w; }
    }
    __syncthreads();
    {
        const int t = tid >> 3, cg = tid & 7;
#pragma unroll
        for (int m2 = 0; m2 < 2; ++m2) { const bf16_t* sT = (m2 ? wT : uT) + (cg * 16) * 72 + t; unsigned short e[16];
#pragma unroll
            for (int j = 0; j < 16; ++j) e[j] = sT[j * 72];
            u32x4 w0, w1; w0.x = e[0] | ((unsigned)e[1] << 16); w0.y = e[2] | ((unsigned)e[3] << 16); w0.z = e[4] | ((unsigned)e[5] << 16); w0.w = e[6] | ((unsigned)e[7] << 16);
            w1.x = e[8] | ((unsigned)e[9] << 16); w1.y = e[10] | ((unsigned)e[11] << 16); w1.z = e[12] | ((unsigned)e[13] << 16); w1.w = e[14] | ((unsigned)e[15] << 16);
            bf16_t* dst = H + (R0 + t) * HN + (m2 ? 2048 : 1536) + h * 128 + cg * 16; *(u32x4*)dst = w0; *(u32x4*)(dst + 8) = w1; } }
    {
        bf16_t* Mb = (bf16_t*)(P.out) + OB_M / 2 + (size_t)task * 16384; bf16_t* Nb = (bf16_t*)((unsigned char*)P.out + OB_N) + (size_t)task * 16384; const float egl = __expf(glast);
        for (int k2 = 0; k2 < 16; ++k2) { const int id = wave * 16 + k2; const bool isn = id >= 64; const int mt = (id & 63) >> 3, nt = id & 7;
            const f32x4 acc = isn ? mma16(uT + mt * 16 * 72, 72, KdT + nt * 16 * 72, 72, 64, (f32x4){0.f, 0.f, 0.f, 0.f}, lane) : mma16(KdT + mt * 16 * 72, 72, wT + nt * 16 * 72, 72, 64, (f32x4){0.f, 0.f, 0.f, 0.f}, lane);
#pragma unroll
            for (int r = 0; r < 4; ++r) { const int i = 16 * mt + 4 * (lane >> 4) + r, j = 16 * nt + (lane & 15);
                if (isn) Nb[i * 128 + j] = f2bf_sw(acc[r]); else Mb[i * 128 + j] = f2bf_sw((i == j ? egl : 0.f) - acc[r]); } } }
    __syncthreads();
}
__device__ __forceinline__ void gdn_chain(const Params& P, unsigned char* lds, int blk) {
    const int tid = threadIdx.x, lane = tid & 63, wave = tid >> 6; const int bh = blk >> 3, v0 = (blk & 7) * 16;
    bf16_t* ST = (bf16_t*)lds;
    for (int i = tid; i < 2 * 16 * 136 / 2; i += 512) ((unsigned*)ST)[i] = 0u;
    const bf16_t* Mb = (const bf16_t*)(P.out) + OB_M / 2 + (size_t)bh * 32 * 16384; bf16_t* Nb = (bf16_t*)((unsigned char*)P.out + OB_N) + (size_t)bh * 32 * 16384;
    const int arow = 16 * wave + (lane & 15), acol = 8 * (lane >> 4), nidx = (v0 + (lane & 15)) * 128 + 16 * wave + 4 * (lane >> 4), sidx = (lane & 15) * 136 + 16 * wave + 4 * (lane >> 4);
    bf16x8 a[4]; u32x2 nv;
#pragma unroll
    for (int kk = 0; kk < 4; ++kk) a[kk] = *(const bf16x8*)(Mb + arow * 128 + acol + 32 * kk);
    nv = *(const u32x2*)(Nb + nidx);
    f32x4 S = (f32x4){0.f, 0.f, 0.f, 0.f};
    __syncthreads();
    int cur = 0;
    for (int c = 0; c < 32; ++c) {
        const int cn = c < 31 ? c + 1 : c; bf16x8 an[4]; u32x2 nn;
#pragma unroll
        for (int kk = 0; kk < 4; ++kk) an[kk] = *(const bf16x8*)(Mb + (size_t)cn * 16384 + arow * 128 + acol + 32 * kk);
        nn = *(const u32x2*)(Nb + (size_t)cn * 16384 + nidx);
        f32x4 acc = (f32x4){0.f, 0.f, 0.f, 0.f};
#pragma unroll
        for (int kk = 0; kk < 4; ++kk) acc = __builtin_amdgcn_mfma_f32_16x16x32_bf16(a[kk], *(const bf16x8*)(ST + cur * 16 * 136 + (lane & 15) * 136 + 8 * (lane >> 4) + 32 * kk), acc, 0, 0, 0);
        S = acc + (f32x4){bflo(nv.x), bfhi(nv.x), bflo(nv.y), bfhi(nv.y)};
        u32x2 sp; sp.x = pk2(S[0], S[1]); sp.y = pk2(S[2], S[3]);
        *(u32x2*)(ST + (cur ^ 1) * 16 * 136 + sidx) = sp;
        *(u32x2*)(Nb + (size_t)c * 16384 + nidx) = sp;
        __syncthreads();
        cur ^= 1;
#pragma unroll
        for (int kk = 0; kk < 4; ++kk) a[kk] = an[kk];
        nv = nn;
    }
    float* so = P.out + O_GDN_P + (size_t)bh * 16384;
#pragma unroll
    for (int r = 0; r < 4; ++r) so[(16 * wave + 4 * (lane >> 4) + r) * 128 + v0 + (lane & 15)] = S[r];
    __syncthreads();
}
__device__ __forceinline__ void gla_scan(const Params& P, int blk) {
    const int tid = threadIdx.x; const int bh = blk >> 3, e = (blk & 7) * 1024 + tid * 2, d = e >> 7;
    bf16_t* GU = (bf16_t*)(P.ws + WS_GU) + (size_t)bh * 32 * 8192 + e; const float* DV = (const float*)(P.ws + WS_DV) + bh * 32 * 64 + d;
    unsigned uw[32]; float dv[32];
#pragma unroll
    for (int c = 0; c < 32; ++c) { uw[c] = *(const unsigned*)(GU + (size_t)c * 8192); dv[c] = DV[c * 64]; }
    float s0 = 0.f, s1 = 0.f;
#pragma unroll
    for (int c = 0; c < 32; ++c) { *(unsigned*)(GU + (size_t)c * 8192) = pk2(s0, s1); s0 = dv[c] * s0 + bflo(uw[c]); s1 = dv[c] * s1 + bfhi(uw[c]); }
    float* so = P.out + O_GLA_P + (size_t)bh * 8192 + e; so[0] = s0; so[1] = s1;
}
__device__ __forceinline__ void gdn_c(const Params& P, unsigned char* lds, int task) {
    const int tid = threadIdx.x, lane = tid & 63, wave = tid >> 6; const int c = task & 31, bh = task >> 5, h = bh & 3, b = bh >> 2;
    const size_t R0 = (size_t)b * 2048 + c * 64;
    const bf16_t* QKV = (const bf16_t*)(P.ws + WS_QKV); const bf16_t* H = (const bf16_t*)(P.ws + WS_H);
    bf16_t* Ws = (bf16_t*)lds; bf16_t* Qg = (bf16_t*)(lds + 17408); bf16_t* ScT = (bf16_t*)(lds + 34816); bf16_t* QKs = (bf16_t*)(lds + 69632); bf16_t* dT = (bf16_t*)(lds + 78848);
    float* ssq = (float*)(lds + 97280);
    const float* GC = (const float*)(P.ws + WS_GC) + task * 64;
    const bf16_t* Nb = (const bf16_t*)((const unsigned char*)P.out + OB_N) + (size_t)(task - 1) * 16384;
    for (int i = tid; i < 1024; i += 512) { const int t = i >> 4, ch = i & 15;
        *(u32x4*)(Ws + t * 136 + ch * 8) = *(const u32x4*)(H + (R0 + t) * HN + 2048 + h * 128 + ch * 8);
        const u32x4 qa = *(const u32x4*)(QKV + (R0 + t) * 1536 + h * 128 + ch * 8); float f[8]; unpack8(qa, f); const float eg = __expf(GC[t]);
        u32x4 w; w.x = pk2(f[0] * eg, f[1] * eg); w.y = pk2(f[2] * eg, f[3] * eg); w.z = pk2(f[4] * eg, f[5] * eg); w.w = pk2(f[6] * eg, f[7] * eg); *(u32x4*)(Qg + t * 136 + ch * 8) = w; }
    for (int i = tid; i < 2048; i += 512) { const int v = i >> 4, ch = i & 15; u32x4 z = (u32x4){0u, 0u, 0u, 0u}; if (c > 0) z = *(const u32x4*)(Nb + v * 128 + ch * 8); *(u32x4*)(ScT + v * 136 + ch * 8) = z; }
    { const int t = tid >> 3, ch = tid & 7; *(u32x4*)(QKs + t * 72 + ch * 8) = *(const u32x4*)(H + (R0 + t) * HN + 2560 + h * 128 + ch * 8); }
    __syncthreads();
    const int mt = wave >> 1, nh = wave & 1; f32x4 o[4];
#pragma unroll
    for (int q = 0; q < 4; ++q) { const int nt = nh * 4 + q;
        const f32x4 ad = mma16(Ws + mt * 16 * 136, 136, ScT + nt * 16 * 136, 136, 128, (f32x4){0.f, 0.f, 0.f, 0.f}, lane);
        o[q] = mma16(Qg + mt * 16 * 136, 136, ScT + nt * 16 * 136, 136, 128, (f32x4){0.f, 0.f, 0.f, 0.f}, lane);
        float dl[4];
#pragma unroll
        for (int r = 0; r < 4; ++r) dl[r] = bf2f(H[(R0 + 16 * mt + 4 * (lane >> 4) + r) * HN + 1536 + h * 128 + 16 * nt + (lane & 15)]) - ad[r];
        u32x2 w; w.x = pk2(dl[0], dl[1]); w.y = pk2(dl[2], dl[3]); *(u32x2*)(dT + (16 * nt + (lane & 15)) * 72 + 16 * mt + 4 * (lane >> 4)) = w; }
    __syncthreads();
#pragma unroll
    for (int q = 0; q < 4; ++q) { const int nt = nh * 4 + q; o[q] = mma16(QKs + mt * 16 * 72, 72, dT + nt * 16 * 72, 72, 64, o[q], lane); }
    mix_out(o, mt, nh, ssq, H + R0 * HN + 3072 + h * 128, (bf16_t*)(P.ws + WS_A) + R0 * DM + 512 + h * 128, P.gdn_ng, lane);
    __syncthreads();
}

#ifndef DIS
#define DIS 0
#endif
__device__ __forceinline__ void zero_fill(float* p, size_t n) { for (size_t i = (size_t)blockIdx.x * 512 + threadIdx.x; i < n; i += (size_t)gridDim.x * 512) p[i] = 0.f; }
__device__ __forceinline__ void phase_m1(const Params& P, unsigned char* lds) {
    if (!(DIS & 1)) for (int task = blockIdx.x; task < 1024; task += gridDim.x) gdn_a(P, lds, task);
    if (!(DIS & 2)) for (int task = blockIdx.x; task < 1024; task += gridDim.x) gla_a(P, lds, task);
    if (!(DIS & 4)) for (int task = blockIdx.x; task < 256; task += gridDim.x) {
        if (task < 128) rec_gdn(P, (float*)lds, 8 + task); else rec_gla(P, (float*)lds, 8 + task - 128);
        __syncthreads(); }
}
__device__ __forceinline__ void phase_m2(const Params& P, unsigned char* lds) {
    for (int blk = blockIdx.x; blk < 256; blk += gridDim.x) { if (!(DIS & 2)) gla_scan(P, blk); if (!(DIS & 1)) gdn_chain(P, lds, blk); }
}
__device__ __forceinline__ void phase_m3(const Params& P, unsigned char* lds) {
    if (!(DIS & 1)) for (int task = blockIdx.x; task < 1024; task += gridDim.x) gdn_c(P, lds, task);
    if (!(DIS & 10)) for (int task = blockIdx.x; task < 1024; task += gridDim.x) gla_c(P, lds, task);
    if (DIS) {
        bf16_t* OM = (bf16_t*)(P.ws + WS_A);
        for (size_t i = (size_t)blockIdx.x * 512 + threadIdx.x; i < (size_t)MT * 512; i += (size_t)gridDim.x * 512) { const size_t row = i >> 9, col = i & 511;
            if ((DIS & 1) && row < NPR) OM[row * DM + 512 + col] = 0; if ((DIS & 10) && row < NPR) OM[row * DM + col] = 0;
            if ((DIS & 4) && row >= NPR) { OM[row * DM + col] = 0; OM[row * DM + 512 + col] = 0; } }
        if (DIS & 1) zero_fill(P.out + O_GDN_P, 524288); if (DIS & 2) zero_fill(P.out + O_GLA_P, 262144);
        if (DIS & 4) { zero_fill(P.out + O_GLA_S, 4194304); zero_fill(P.out + O_GDN_S, 8388608); } }
}

template <int WHICH>
__device__ __forceinline__ void phase_ln(const Params& P) {
    const int tid = threadIdx.x, lane = tid & 63, wave = tid >> 6, gw = blockIdx.x * 8 + wave, NGW = gridDim.x * 8;
    const float* G = WHICH == 1 ? P.ln1g : P.ln2g; const float* B = WHICH == 1 ? P.ln1b : P.ln2b;
    f32x4 g4[4], b4[4];
#pragma unroll
    for (int j = 0; j < 4; ++j) { g4[j] = *(const f32x4*)(G + lane * 4 + 256 * j); b4[j] = *(const f32x4*)(B + lane * 4 + 256 * j); }
    float* X1F = (float*)(P.ws + WS_X1F); bf16_t* X1B = (bf16_t*)(P.ws + WS_A);
    for (int row = gw; row < MT; row += NGW) {
        const float* base = WHICH == 1 ? (row < NPR ? P.xp + (size_t)row * DM : P.xs + (size_t)(row - NPR) * DM) : X1F + (size_t)row * DM;
        float* mrow = P.out + O_Y + (size_t)row * DM;
        f32x4 v[4]; float s = 0.f;
#pragma unroll
        for (int j = 0; j < 4; ++j) { const f32x4 xb = *(const f32x4*)(base + lane * 4 + 256 * j), mm = *(const f32x4*)(mrow + lane * 4 + 256 * j); v[j] = DN_ALPHA * xb + mm; s += (v[j][0] + v[j][1]) + (v[j][2] + v[j][3]); }
        const float mean = wave_sum(s) * (1.0f / DM); float q = 0.f;
#pragma unroll
        for (int j = 0; j < 4; ++j) { v[j] = v[j] - mean; q += (v[j][0] * v[j][0] + v[j][1] * v[j][1]) + (v[j][2] * v[j][2] + v[j][3] * v[j][3]); }
        const float rstd = rsqrtf(wave_sum(q) * (1.0f / DM) + 1e-5f);
#pragma unroll
        for (int j = 0; j < 4; ++j) { const f32x4 o = v[j] * rstd * g4[j] + b4[j];
            if (WHICH == 1) { *(f32x4*)(X1F + (size_t)row * DM + lane * 4 + 256 * j) = o; u32x2 w; w.x = pk2(o[0], o[1]); w.y = pk2(o[2], o[3]); *(u32x2*)(X1B + (size_t)row * DM + lane * 4 + 256 * j) = w; }
            else *(f32x4*)(mrow + lane * 4 + 256 * j) = o; }
    }
}

constexpr int NPHASE = 11;
__global__ void __launch_bounds__(512, 2) mega(Params P) {
    extern __shared__ __attribute__((aligned(16))) unsigned char lds[];
    cg::grid_group grid = cg::this_grid();
    const int lo = P.lo, hi = P.hi;
#ifndef PHASE_MASK
#define PHASE_MASK 0x7ff
#endif
#define IN(k) (((PHASE_MASK >> (k)) & 1) && lo <= (k) && (k) < hi)
#define SEAM(k) do { if (IN(k) && IN((k) + 1)) grid.sync(); } while (0)
    if (IN(0)) phase_convert(P, lds);
    SEAM(0);
    if (IN(1)) { pg8::Gemm g{(const bf16_t*)(P.ws + WS_A), (const bf16_t*)(P.ws + WS_WIN), MT, N1, DM}; pg8::StaticOrder S; S.init(MT, N1, gridDim.x, blockIdx.x);
        EpiH E{(bf16_t*)(P.ws + WS_H), (float*)(P.ws + WS_HS)}; pg8::gemm_phase<EpiH, pg8::StaticOrder, false>((PG8_LAS unsigned char*)lds, g, S, E, nullptr); }
    SEAM(1);
    if (IN(2)) phase_prep(P);
    SEAM(2);
    if (IN(3)) phase_m1(P, lds);
    SEAM(3);
    if (IN(4)) phase_m2(P, lds);
    SEAM(4);
    if (IN(5)) phase_m3(P, lds);
    SEAM(5);
    if (IN(6)) { pg8::Gemm g{(const bf16_t*)(P.ws + WS_A), (const bf16_t*)(P.ws + WS_WOUT), MT, DM, DM}; pg8::StaticOrder S; S.init(MT, DM, gridDim.x, blockIdx.x);
        pg8::EpiF32 E{P.out + O_Y, DM, nullptr}; pg8::gemm_phase<pg8::EpiF32, pg8::StaticOrder, false>((PG8_LAS unsigned char*)lds, g, S, E, nullptr); }
    SEAM(6);
    if (IN(7)) phase_ln<1>(P);
    SEAM(7);
    if (IN(8)) { pg8::Gemm g{(const bf16_t*)(P.ws + WS_A), (const bf16_t*)(P.ws + WS_WGU), MT, NGU, DM}; pg8::StaticOrder S; S.init(MT, NGU, gridDim.x, blockIdx.x);
        EpiSwiGLU E{(bf16_t*)(P.ws + WS_HID)}; pg8::gemm_phase<EpiSwiGLU, pg8::StaticOrder, false>((PG8_LAS unsigned char*)lds, g, S, E, nullptr); }
    SEAM(8);
    if (IN(9)) { pg8::Gemm g{(const bf16_t*)(P.ws + WS_HID), (const bf16_t*)(P.ws + WS_WD), MT, DM, FF}; pg8::StaticOrder S; S.init(MT, DM, gridDim.x, blockIdx.x);
        pg8::EpiF32 E{P.out + O_Y, DM, nullptr}; pg8::gemm_phase<pg8::EpiF32, pg8::StaticOrder, false>((PG8_LAS unsigned char*)lds, g, S, E, nullptr); }
    SEAM(9);
    if (IN(10)) phase_ln<2>(P);
#undef IN
#undef SEAM
}

#ifndef N_LAUNCHES
#define N_LAUNCHES 1
#endif
extern "C" void kernel_launch(void* const* d_in, const int* in_sizes, int n_in, void* d_out, int out_size, void* d_ws, size_t ws_size, hipStream_t stream) {
    static int grid = 0;
    constexpr int LDS_BYTES = pg8::STAGE_BYTES;
    if (grid == 0) {
        if (n_in != 21 || ws_size < WS_END2) { fprintf(stderr, "kernel_launch: need 21 inputs and %zu bytes of workspace, got %d and %zu\n", (size_t)WS_END2, n_in, ws_size); grid = -1; return; }
        int dev = 0, cus = 0, per_cu = 0;
        (void)hipGetDevice(&dev); (void)hipDeviceGetAttribute(&cus, hipDeviceAttributeMultiprocessorCount, dev);
        if (hipFuncSetAttribute((const void*)mega, hipFuncAttributeMaxDynamicSharedMemorySize, LDS_BYTES) != hipSuccess) { fprintf(stderr, "kernel_launch: hipFuncSetAttribute failed\n"); grid = -1; return; }
        (void)hipOccupancyMaxActiveBlocksPerMultiprocessor(&per_cu, (const void*)mega, 512, LDS_BYTES);
        (void)hipGetLastError();
        grid = cus;
        if (per_cu < 1) fprintf(stderr, "kernel_launch: occupancy query says %d blocks per CU\n", per_cu);
    }
    if (grid < 0) return;
    Params p{};
    const float** pp = (const float**)&p;
    for (int i = 0; i < 21; ++i) pp[i] = (const float*)d_in[i];
    p.out = (float*)d_out; p.ws = (unsigned char*)d_ws;
    const int cuts = N_LAUNCHES;
    for (int li = 0; li < cuts; ++li) {
        p.lo = (cuts == 1) ? 0 : li; p.hi = (cuts == 1) ? NPHASE : li + 1;
        void* args[] = {&p};
        hipError_t e = hipLaunchCooperativeKernel((const void*)mega, dim3(grid), dim3(512), args, LDS_BYTES, stream);
        if (e != hipSuccess) { fprintf(stderr, "cooperative launch %d failed: %s (grid %d)\n", li, hipGetErrorString(e), grid); break; }
    }
}
```
